# Optimizing an MI355X kernel written in HIP

```python
import math
import jax, jax.numpy as jnp
from jax import lax
import numpy as np

D_MODEL = 1024
BATCH = 8
SEQ = 4096
DEPTH = 2

GRID_W = 64
CTX_LEN = 256
HEAD_DIM = 64
ROPE_BASE = 10000.0
RMS_EPS = 1e-6

GLA_HEADS = 4
GLA_DK = 32
GLA_DV = 64
GLA_LR = 16
GLA_NORMALIZER = 16.0
GLA_CHUNK = 64
DIFF_HEADS = 4
DIFF_HD = 64
DIFF_QB = 128
NA_HEADS = 4
NA_HD = 64
WIN_R = 8
WIN_C = 16

GLA_QK = GLA_HEADS * GLA_DK
GLA_V = GLA_HEADS * GLA_DV
DIFF_QK = DIFF_HEADS * 2 * DIFF_HD
DIFF_V = DIFF_HEADS * 2 * DIFF_HD
NA_W = NA_HEADS * NA_HD
MIX_WIDTH = GLA_V + DIFF_V + NA_W
IN_NAMES = ('gq', 'gk', 'gv', 'gg', 'gdf', 'gdb', 'dq', 'dk', 'dv', 'nq', 'nk', 'nv')
IN_SIZES = (GLA_QK, GLA_QK, GLA_V, GLA_V, GLA_LR, GLA_LR, DIFF_QK, DIFF_QK, DIFF_V, NA_W, NA_W, NA_W)
IN_COLS = sum(IN_SIZES)

FFN_DENSE = 2816
N_EXPERTS = 8
TOP_K = 2
FFN_EXPERT = 3584
N_DENSE = (DEPTH + 1) // 2
N_MOE = DEPTH // 2

kernel_name = 'hymba_gla_diff_natten_moe_prefix_dit'


def rmsnorm(x, g):
    xf = x.astype(jnp.float32)
    y = xf * lax.rsqrt(jnp.mean(xf * xf, axis=-1, keepdims=True) + RMS_EPS)
    return (y * g.astype(jnp.float32)).astype(x.dtype)


def modulate(h, shift, scale):
    return h * (1.0 + scale) + shift


def project(h, w_in):
    z = jnp.einsum('bld,de->ble', h, w_in)
    offs = [int(o) for o in np.cumsum(IN_SIZES)[:-1]]
    return dict(zip(IN_NAMES, jnp.split(z, offs, axis=-1)))


def axial_rope_angles(n_tokens):
    t = jnp.arange(n_tokens)
    row = (t // GRID_W).astype(jnp.float32)
    col = (t % GRID_W).astype(jnp.float32)
    quarter = HEAD_DIM // 4
    inv = 1.0 / (ROPE_BASE ** (jnp.arange(quarter, dtype=jnp.float32) / quarter))
    return row[:, None] * inv, col[:, None] * inv


def rope_rotate(x, ang):
    x1, x2 = jnp.split(x, 2, axis=-1)
    cos, sin = jnp.cos(ang), jnp.sin(ang)
    return jnp.concatenate([x1 * cos - x2 * sin, x1 * sin + x2 * cos], axis=-1)


def apply_axial_rope(x, ang_r, ang_c):
    xf = x.astype(jnp.float32)
    half = HEAD_DIM // 2
    ar = ang_r[:, None, None, :]
    ac = ang_c[:, None, None, :]
    out = jnp.concatenate([rope_rotate(xf[..., :half], ar), rope_rotate(xf[..., half:], ac)], axis=-1)
    return out.astype(x.dtype)


def gla_log_decay(zd, w_up, b):
    logits = jnp.einsum('blr,rk->blk', zd, w_up) + b
    return jax.nn.log_sigmoid(logits.astype(jnp.float32)) / GLA_NORMALIZER


def gla_inputs(p, w_dec_up, b_dec):
    B, L, _ = p['gq'].shape
    heads = lambda t, d: t.reshape(B, L, GLA_HEADS, d)
    q = heads(p['gq'], GLA_DK) * GLA_DK ** -0.5
    k = heads(p['gk'], GLA_DK)
    v = heads(p['gv'], GLA_DV)
    lg_f = heads(gla_log_decay(p['gdf'], w_dec_up[0], b_dec[0]), GLA_DK)
    lg_b = heads(gla_log_decay(p['gdb'], w_dec_up[1], b_dec[1]), GLA_DK)
    return q, k, v, lg_f, lg_b


def gla_chunked(q, k, v, log_g, s0, with_output):
    B, L, H, _ = q.shape
    dv = v.shape[-1]
    n = L // GLA_CHUNK
    blk = lambda t: t.astype(jnp.float32).reshape(B, n, GLA_CHUNK, H, t.shape[-1])
    q, k, v, log_g = blk(q), blk(k), blk(v), blk(log_g)
    b = jnp.cumsum(log_g, axis=2)
    b_end = b[:, :, -1]
    k_end = k * jnp.exp(b_end[:, :, None] - b)
    u = jnp.einsum('bnshk,bnshv->bnhkv', k_end, v)

    def step(s, inp):
        lb, u_c = inp
        return jnp.exp(lb)[..., None] * s + u_c, s

    s_fin, s_prev = lax.scan(step, s0, (jnp.moveaxis(b_end, 1, 0), jnp.moveaxis(u, 1, 0)))
    if not with_output:
        return None, s_fin
    q_dec = q * jnp.exp(b)
    k_inv = k * jnp.exp(-b)
    lower = jnp.tril(jnp.ones((GLA_CHUNK, GLA_CHUNK), dtype=bool))
    att = jnp.where(lower, jnp.einsum('bnchk,bnshk->bnhcs', q_dec, k_inv), 0.0)
    o = (jnp.einsum('bnhcs,bnshv->bnchv', att, v)
         + jnp.einsum('bnchk,nbhkv->bnchv', q_dec, s_prev))
    return o.reshape(B, L, H, dv), s_fin


def gla_bidir(q, k, v, lg_f, lg_b, s0_f, s0_b, with_output):
    flip = lambda t: jnp.flip(t, axis=1)
    o_f, s_f = gla_chunked(q, k, v, lg_f, s0_f, with_output)
    o_b, s_b = gla_chunked(flip(q), flip(k), flip(v), flip(lg_b), s0_b, with_output)
    o = o_f + flip(o_b) if with_output else None
    return o, s_f, s_b


def gla_out(o, gate, g):
    B, L = o.shape[:2]
    o = rmsnorm(o, g).reshape(B, L, GLA_V).astype(gate.dtype)
    return o * jax.nn.silu(gate)


def diff_lambda_value(lam, layer_idx):
    lam_init = 0.8 - 0.6 * math.exp(-0.3 * layer_idx)
    lf = lam.astype(jnp.float32)
    lam_full = jnp.exp(jnp.sum(lf[0] * lf[1])) - jnp.exp(jnp.sum(lf[2] * lf[3])) + lam_init
    return lam_full, lam_init


def diff_attend(q, k, v, lam):
    s = jnp.einsum('bhmqd,bhmkd->bhmqk', q * DIFF_HD ** -0.5, k).astype(jnp.float32)
    p = jax.nn.softmax(s, axis=-1)
    a = p[:, :, 0] - lam * p[:, :, 1]
    return jnp.einsum('bhqk,bhkv->bhqv', a.astype(v.dtype), v)


def diff_blocked(q, k, v, lam):
    B, H, M, L, d = q.shape
    nb = L // DIFF_QB
    qb = jnp.moveaxis(q.reshape(B, H, M, nb, DIFF_QB, d), 3, 0)
    ob = lax.map(lambda qq: diff_attend(qq, k, v, lam), qb)
    return jnp.moveaxis(ob, 0, 2).reshape(B, H, L, v.shape[-1])


def diff_out(o, g, lam_init):
    o = rmsnorm(o, g) * (1.0 - lam_init)
    B, H, L, dv = o.shape
    return o.transpose(0, 2, 1, 3).reshape(B, L, H * dv)


def neighbourhood_attention(q, k, v, k_ctx, v_ctx, rpb):
    B, S, H, d = q.shape
    rows = S // GRID_W
    wr = min(WIN_R, rows)
    grid = lambda t: t.reshape(B, rows, GRID_W, H, d)
    qg, kg, vg = grid(q), grid(k), grid(v)
    cols = jnp.arange(GRID_W)
    cstart = jnp.clip(cols - WIN_C // 2, 0, GRID_W - WIN_C)
    cidx = cstart[:, None] + jnp.arange(WIN_C)[None, :]
    cbias = cidx - cols[:, None] + WIN_C - 1
    nloc = wr * WIN_C
    scale = d ** -0.5

    def row_fn(r):
        rs = jnp.clip(r - WIN_R // 2, 0, rows - wr)
        kw = lax.dynamic_slice_in_dim(kg, rs, wr, axis=1)[:, :, cidx]
        vw = lax.dynamic_slice_in_dim(vg, rs, wr, axis=1)[:, :, cidx]
        qr = lax.dynamic_index_in_dim(qg, r, axis=1, keepdims=False) * scale
        rbias = rs + jnp.arange(wr) - r + WIN_R - 1
        bias = rpb[:, rbias[None, :, None], cbias[:, None, :]]
        s_loc = jnp.einsum('bchd,brcjhd->bhcrj', qr, kw).astype(jnp.float32) + bias.astype(jnp.float32)
        s_ctx = jnp.einsum('bchd,bkhd->bhck', qr, k_ctx).astype(jnp.float32)
        s = jnp.concatenate([s_loc.reshape(B, H, GRID_W, nloc), s_ctx], axis=-1)
        p = jax.nn.softmax(s, axis=-1).astype(v.dtype)
        p_loc = p[..., :nloc].reshape(B, H, GRID_W, wr, WIN_C)
        p_ctx = p[..., nloc:]
        return (jnp.einsum('bhcrj,brcjhd->bchd', p_loc, vw)
                + jnp.einsum('bhck,bkhd->bchd', p_ctx, v_ctx))

    out = lax.map(row_fn, jnp.arange(rows))
    return jnp.moveaxis(out, 0, 1).reshape(B, S, H * d)


def softmax_attend(q, k, v):
    s = jnp.einsum('bqhd,bkhd->bhqk', q * q.shape[-1] ** -0.5, k).astype(jnp.float32)
    p = jax.nn.softmax(s, axis=-1).astype(v.dtype)
    return jnp.einsum('bhqk,bkhd->bqhd', p, v)


def mixer(h_lat, h_ctx, w_in, w_dec_up, b_dec, g_gla, lam, g_diff, rpb, w_out,
          layer_idx, ang_r, ang_c, with_ctx_out):
    B, S, _ = h_lat.shape
    C = h_ctx.shape[1]
    pl, pc = project(h_lat, w_in), project(h_ctx, w_in)

    ql, kl, vl, lfl, lbl = gla_inputs(pl, w_dec_up, b_dec)
    qc, kc, vc, lfc, lbc = gla_inputs(pc, w_dec_up, b_dec)
    zero = jnp.zeros((B, GLA_HEADS, GLA_DK, GLA_DV), jnp.float32)
    oc_gla, s_f, s_b = gla_bidir(qc, kc, vc, lfc, lbc, zero, zero, with_ctx_out)
    ol_gla, _, _ = gla_bidir(ql, kl, vl, lfl, lbl, s_f, s_b, True)
    a_lat = gla_out(ol_gla, pl['gg'], g_gla)

    lam_full, lam_init = diff_lambda_value(lam, layer_idx)

    def diff_qkv(p, L):
        return (p['dq'].reshape(B, L, DIFF_HEADS, 2, DIFF_HD),
                p['dk'].reshape(B, L, DIFF_HEADS, 2, DIFF_HD),
                p['dv'].reshape(B, L, DIFF_HEADS, 2 * DIFF_HD))

    dql, dkl, dvl = diff_qkv(pl, S)
    dql = apply_axial_rope(dql, ang_r, ang_c)
    dkl = apply_axial_rope(dkl, ang_r, ang_c)
    dqc, dkc, dvc = diff_qkv(pc, C)
    maps_first = lambda t: t.transpose(0, 2, 3, 1, 4)
    heads_first = lambda t: t.transpose(0, 2, 1, 3)
    k_all = jnp.concatenate([maps_first(dkl), maps_first(dkc)], axis=3)
    v_all = jnp.concatenate([heads_first(dvl), heads_first(dvc)], axis=2)
    b_lat = diff_out(diff_blocked(maps_first(dql), k_all, v_all, lam_full), g_diff, lam_init)

    na = lambda p, name, L: p[name].reshape(B, L, NA_HEADS, NA_HD)
    nkc, nvc = na(pc, 'nk', C), na(pc, 'nv', C)
    c_lat = neighbourhood_attention(na(pl, 'nq', S), na(pl, 'nk', S), na(pl, 'nv', S), nkc, nvc, rpb)

    y_lat = jnp.concatenate([a_lat, b_lat, c_lat], axis=-1) @ w_out
    if not with_ctx_out:
        return y_lat, None
    a_ctx = gla_out(oc_gla, pc['gg'], g_gla)
    b_ctx = diff_out(diff_attend(maps_first(dqc), maps_first(dkc), heads_first(dvc), lam_full), g_diff, lam_init)
    c_ctx = softmax_attend(na(pc, 'nq', C), nkc, nvc).reshape(B, C, NA_W)
    y_ctx = jnp.concatenate([a_ctx, b_ctx, c_ctx], axis=-1) @ w_out
    return y_lat, y_ctx


def swiglu(h, wg, wu, wd):
    return (jax.nn.silu(h @ wg) * (h @ wu)) @ wd


def moe_swiglu(h, w_router, wg, wu, wd):
    shp = h.shape
    t = h.reshape(-1, shp[-1])
    logits = (t @ w_router).astype(jnp.float32)
    top_v, top_i = lax.top_k(logits, TOP_K)
    top_w = jax.nn.softmax(top_v, axis=-1)
    gates = jnp.sum(jax.nn.one_hot(top_i, N_EXPERTS, dtype=jnp.float32) * top_w[..., None], axis=1)
    y = jnp.zeros_like(t)
    for e in range(N_EXPERTS):
        y = y + gates[:, e:e + 1].astype(t.dtype) * swiglu(t, wg[e], wu[e], wd[e])
    return y.reshape(shp)


def setup_inputs(seed: int = 0) -> dict:
    key = jax.random.key(seed)
    ks = jax.random.split(key, 24)
    f32 = jnp.float32
    nrm = lambda k, shape, s: jax.random.normal(k, shape, f32) * s
    D = D_MODEL
    return {
        'x': nrm(ks[0], (BATCH, SEQ, D), 1.0),
        'c': nrm(ks[1], (BATCH, D), 1.0),
        'ctx': nrm(ks[2], (BATCH, CTX_LEN, D), 1.0),
        'c_ctx': nrm(ks[3], (D,), 1.0),
        'w_mod': nrm(ks[4], (DEPTH, D, 6 * D), 0.5 * D ** -0.5),
        'b_mod': nrm(ks[5], (DEPTH, 6 * D), 0.01),
        'g_norm1': 1.0 + nrm(ks[6], (DEPTH, D), 0.1),
        'g_norm2': 1.0 + nrm(ks[7], (DEPTH, D), 0.1),
        'w_in': nrm(ks[8], (DEPTH, D, IN_COLS), D ** -0.5),
        'gla_w_dec_up': nrm(ks[9], (DEPTH, 2, GLA_LR, GLA_QK), GLA_LR ** -0.5),
        'gla_b_dec': nrm(ks[10], (DEPTH, 2, GLA_QK), 0.1),
        'gla_g_norm': 1.0 + nrm(ks[11], (DEPTH, GLA_DV), 0.1),
        'diff_lambda': nrm(ks[12], (DEPTH, 4, DIFF_HD), 0.1),
        'diff_g_norm': 1.0 + nrm(ks[13], (DEPTH, 2 * DIFF_HD), 0.1),
        'na_rpb': nrm(ks[14], (DEPTH, NA_HEADS, 2 * WIN_R - 1, 2 * WIN_C - 1), 0.1),
        'w_out': nrm(ks[15], (DEPTH, MIX_WIDTH, D), MIX_WIDTH ** -0.5),
        'w_ffn_gate': nrm(ks[16], (N_DENSE, D, FFN_DENSE), D ** -0.5),
        'w_ffn_up': nrm(ks[17], (N_DENSE, D, FFN_DENSE), D ** -0.5),
        'w_ffn_down': nrm(ks[18], (N_DENSE, FFN_DENSE, D), FFN_DENSE ** -0.5),
        'w_router': nrm(ks[19], (N_MOE, D, N_EXPERTS), D ** -0.5),
        'w_moe_gate': nrm(ks[20], (N_MOE, N_EXPERTS, D, FFN_EXPERT), D ** -0.5),
        'w_moe_up': nrm(ks[21], (N_MOE, N_EXPERTS, D, FFN_EXPERT), D ** -0.5),
        'w_moe_down': nrm(ks[22], (N_MOE, N_EXPERTS, FFN_EXPERT, D), FFN_EXPERT ** -0.5),
        'g_final': 1.0 + nrm(ks[23], (D,), 0.1),
    }


def reference(x, c, ctx, c_ctx, w_mod, b_mod, g_norm1, g_norm2, w_in, gla_w_dec_up, gla_b_dec,
              gla_g_norm, diff_lambda, diff_g_norm, na_rpb, w_out, w_ffn_gate, w_ffn_up, w_ffn_down,
              w_router, w_moe_gate, w_moe_up, w_moe_down, g_final):
    S = x.shape[1]
    ang_r, ang_c = axial_rope_angles(S)
    ctx_s = ctx
    for l in range(DEPTH):
        last = l == DEPTH - 1
        sh1, sc1, ga1, sh2, sc2, ga2 = jnp.split(jax.nn.silu(c) @ w_mod[l] + b_mod[l], 6, axis=-1)
        csh1, csc1, cga1, csh2, csc2, cga2 = jnp.split(jax.nn.silu(c_ctx) @ w_mod[l] + b_mod[l], 6, axis=-1)

        h_lat = modulate(rmsnorm(x, g_norm1[l]), sh1[:, None], sc1[:, None])
        h_ctx = modulate(rmsnorm(ctx_s, g_norm1[l]), csh1, csc1)
        y_lat, y_ctx = mixer(h_lat, h_ctx, w_in[l], gla_w_dec_up[l], gla_b_dec[l], gla_g_norm[l],
                             diff_lambda[l], diff_g_norm[l], na_rpb[l], w_out[l],
                             l, ang_r, ang_c, not last)
        x = x + ga1[:, None] * y_lat
        if not last:
            ctx_s = ctx_s + cga1 * y_ctx

        if l % 2 == 0:
            i = l // 2
            ffn = lambda h, i=i: swiglu(h, w_ffn_gate[i], w_ffn_up[i], w_ffn_down[i])
        else:
            i = l // 2
            ffn = lambda h, i=i: moe_swiglu(h, w_router[i], w_moe_gate[i], w_moe_up[i], w_moe_down[i])
        h_lat = modulate(rmsnorm(x, g_norm2[l]), sh2[:, None], sc2[:, None])
        x = x + ga2[:, None] * ffn(h_lat)
        if not last:
            h_ctx = modulate(rmsnorm(ctx_s, g_norm2[l]), csh2, csc2)
            ctx_s = ctx_s + cga2 * ffn(h_ctx)
    return rmsnorm(x, g_final)
```

```cpp
#include <hip/hip_runtime.h>
#include <cstdio>
#include <cstdint>

#define LAS __attribute__((address_space(3)))
#define GAS __attribute__((address_space(1)))
typedef unsigned short bf16;
typedef short bf16x8 __attribute__((ext_vector_type(8)));
typedef float f32x4 __attribute__((ext_vector_type(4)));
typedef float f32x2 __attribute__((ext_vector_type(2)));
typedef unsigned u32x4 __attribute__((ext_vector_type(4)));
typedef unsigned u32x2 __attribute__((ext_vector_type(2)));

constexpr int NB = 8, SEQ = 4096, CTX = 256, DM = 1024, RPB = CTX + SEQ, NROW = NB * RPB;
constexpr int NLAT = NB * SEQ;
constexpr int NZ = 3328;
constexpr int ZGQ = 0, ZGK = 128, ZGV = 256, ZGG = 512, ZDQ = 768, ZDK = 1280, ZDV = 1792, ZNQ = 2304, ZNK = 2560, ZNV = 2816, ZLG = 3072;
constexpr int FFD = 2816, FFE = 3584, NEXP = 8;
constexpr int NCH = RPB / 64;
constexpr float RMS_EPS = 1e-6f;
constexpr float LOG2E = 1.4426950408889634f;
constexpr float QSCALE = 0.125f * LOG2E;
constexpr int PASS0_TILES = 128, PASS1_MAX = 136;

constexpr size_t MiB = 1u << 20;
constexpr size_t WS_CTL = 0, CTL_ZERO_BYTES = 65536;
constexpr size_t WS_SM = 1 * MiB;
constexpr size_t SM_ROPE = 448 * 1024, SM_LAM = 460 * 1024;
constexpr size_t SM_SWGU = 480 * 1024, SM_SWIN = 704 * 1024;
constexpr size_t WS_XS = 503 * MiB, WS_SS = 571 * MiB;
constexpr size_t WS_ML = 2 * MiB;
constexpr size_t ML_TOKINFO = 1 * MiB, ML_ROWLIST = 1536 * 1024;
constexpr size_t WS_XC = 4 * MiB;
constexpr size_t WS_HB = 12 * MiB;
constexpr size_t WS_CB = WS_HB;
constexpr size_t WS_MW = 80 * MiB;
constexpr size_t MW_STRIDE = 21 * MiB, MW_DN = 14 * MiB;
constexpr size_t WS_W = 248 * MiB;
constexpr size_t W_IN0 = WS_W, W_IN1 = WS_W + 6656 * 1024, W_OUT0 = WS_W + 13 * MiB, W_OUT1 = WS_W + 15 * MiB, W_GU = WS_W + 17 * MiB, W_DN = WS_W + 28 * MiB;
constexpr size_t WS_ZB = 282 * MiB;
constexpr size_t WS_U = 503 * MiB, WS_SP = 537 * MiB, WS_BE = 571 * MiB;
constexpr size_t WS_AB = 282 * MiB;
constexpr size_t WS_YB0 = 520 * MiB;
constexpr size_t WS_END = 584 * MiB;
static_assert(WS_HB + (size_t)NROW * DM * 2 <= WS_MW && WS_MW + 8 * MW_STRIDE <= WS_W && W_DN + (size_t)DM * FFD * 2 <= WS_ZB && WS_ZB + (size_t)NROW * NZ * 2 <= WS_U, "ws map");
static_assert(WS_U + (size_t)NB * 2 * 4 * NCH * 2048 * 4 <= WS_SP && WS_SP + (size_t)NB * 2 * 4 * NCH * 2048 * 4 <= WS_BE && WS_BE + (size_t)NB * 2 * 4 * NCH * 32 * 4 <= WS_END, "ws map gla");
static_assert(WS_AB + (size_t)PASS1_MAX * 256 * FFE * 2 <= WS_YB0 && WS_YB0 + (size_t)PASS0_TILES * 256 * DM * 2 <= WS_END && (size_t)PASS1_MAX * 256 * DM * 2 <= (size_t)NROW * DM * 2, "ws map moe");
static_assert(WS_ZB + (size_t)NROW * FFD * 2 <= WS_U, "dense activation overlay");
constexpr int CW_TMO = 0, CW_BAR = 4096, CW_CNT = 8192;
static_assert((CW_CNT + 64 * 8) * 4 <= (int)CTL_ZERO_BYTES && (CW_BAR + 3456) <= CW_CNT, "control words inside the memset region");

constexpr int RING_BYTES = 131072, MISC_OFF = RING_BYTES + 320, LDS_BYTES = 163840;

__device__ __forceinline__ float bf2f(bf16 v) { return __uint_as_float(((unsigned)v) << 16); }
__device__ __forceinline__ unsigned f2bf(float f) { unsigned u = __float_as_uint(f); return (u + 0x7fffu + ((u >> 16) & 1u)) >> 16; }
__device__ __forceinline__ unsigned pk2(float lo, float hi) { return f2bf(lo) | (f2bf(hi) << 16); }
__device__ __forceinline__ float wave_sum(float v) {
#pragma unroll
    for (int o = 1; o < 64; o <<= 1) v += __shfl_xor(v, o);
    return v;
}
__device__ __forceinline__ float silu_f(float x) { return x / (1.0f + __expf(-x)); }

namespace pg8 {
#define PG8_LAS __attribute__((address_space(3)))
typedef unsigned short bf16_t;
constexpr int BM = 256, BK = 64, HALF = 128, HTB = HALF * BK * 2, STAGE_BYTES = 8 * HTB, NXCD = 8, WGM = 8;
constexpr int GROWS_OFF = 131520, GROWS_MAX = 15;
__host__ __device__ __forceinline__ int lds_byte(int r, int c) { const int st = (r >> 4) * 2 + (c >> 5), rr = r & 15, cc = c & 31, ob = rr * 64 + cc * 2; return st * 1024 + (ob ^ (((ob >> 9) & 1) << 5)); }
__host__ __device__ __forceinline__ void stage_rc(int b, int& R, int& C) { const int st = b / 1024, sb = b % 1024, swz = sb ^ (((sb >> 9) & 1) << 5); R = (st >> 1) * 16 + swz / 64; C = (st & 1) * 32 + (swz % 64) / 2; }
__host__ __device__ __forceinline__ int perm32(int rho) { const int n = rho >> 4, i = rho & 15; return 8 * (i >> 2) + 4 * n + (i & 3); }

struct Unit { int pm, pn, ga; long bo; long ko; int ks; int sl; };
struct Gemm { const bf16_t* A; const bf16_t* Bt; int K; const int* rows; int Kloop; };

__device__ __forceinline__ bool tile_order(int i, int G, int c, int nM, int nN, int& pm, int& pn) {
    const int nwg = nM * nN; const long L = (long)i * G + c; if (L >= nwg) return false;
    int wgid = (int)L; { const int q = nwg / NXCD, r = nwg % NXCD, xcd = wgid % NXCD, off = wgid / NXCD; wgid = (xcd < r ? xcd * (q + 1) : r * (q + 1) + (xcd - r) * q) + off; }
    const int nig = WGM * nN, gid = wgid / nig, fm = gid * WGM, gsz = (nM - fm) < WGM ? (nM - fm) : WGM;
    pm = fm + ((wgid % nig) % gsz); pn = (wgid % nig) / gsz; return true;
}
struct RowOrder {
    int nM, nN, G, c, K; bool skipctx;
    __device__ __forceinline__ bool next(int i, Unit& u) const {
        int pm, pn; if (!tile_order(i, G, c, nM, nN, pm, pn)) return false;
        u.pm = skipctx ? 17 * (pm >> 4) + 1 + (pm & 15) : pm; u.pn = pn; u.ga = 0; u.bo = (long)pn * 256 * K * 2; u.ko = 0; u.ks = 0; u.sl = i; return true;
    }
};
struct MoeOrder {
    int nM, nN, G, c, K, tile0; int tb[8]; long estride;
    __device__ __forceinline__ bool next(int i, Unit& u) const {
        int pm, pn; if (!tile_order(i, G, c, nM, nN, pm, pn)) return false;
        u.pm = pm; u.pn = pn; u.ga = tile0 + pm; int e = 0;
#pragma unroll
        for (int k = 1; k < 8; ++k) e += (u.ga >= tb[k]) ? 1 : 0;
        u.bo = (long)e * estride + (long)pn * 256 * K * 2; u.ko = 0; u.ks = 0; u.sl = i; return true;
    }
};
struct MoeSplitOrder {
    int nM, nN, KS, G, c, K, Kloop, tile0; int tb[8]; long estride;
    __device__ __forceinline__ bool next(int i, Unit& u) const {
        const long L = (long)i * G + c; if (L >= (long)nM * nN * KS) return false;
        const int ks = (int)(L % KS), r = (int)(L / KS); u.pn = r % nN; u.pm = r / nN; u.ga = tile0 + u.pm; int e = 0;
#pragma unroll
        for (int k = 1; k < 8; ++k) e += (u.ga >= tb[k]) ? 1 : 0;
        u.bo = (long)e * estride + (long)u.pn * 256 * K * 2; u.ko = (long)ks * Kloop * 2; u.ks = ks; u.sl = i; return true;
    }
};

__device__ __forceinline__ unsigned cvt_pk_bf16(float lo, float hi) { unsigned r; asm volatile("v_cvt_pk_bf16_f32 %0, %1, %2" : "=v"(r) : "v"(lo), "v"(hi)); return r; }

struct EpiBf16 {
    static constexpr bool PERM = true;
    bf16_t* O; int ldc; size_t slab;
    __device__ __forceinline__ void operator()(const f32x4 (&acc)[2][2][4][2], const Unit& u, int wr, int wc, int fr, int fq) const {
        const int row0 = u.pm * BM + wr * 64 + fr, col0 = u.pn * BM + wc * 32 + 8 * fq; bf16_t* Ob = O + (size_t)u.ks * slab;
#pragma unroll
        for (int ai = 0; ai < 2; ++ai)
#pragma unroll
            for (int m = 0; m < 4; ++m) { bf16_t* rowp = Ob + (size_t)(row0 + ai * HALF + m * 16) * ldc + col0;
#pragma unroll
                for (int bj = 0; bj < 2; ++bj) { const f32x4 v0 = acc[ai][bj][m][0], v1 = acc[ai][bj][m][1];
                    u32x4 w; w.x = cvt_pk_bf16(v0[0], v0[1]); w.y = cvt_pk_bf16(v0[2], v0[3]); w.z = cvt_pk_bf16(v1[0], v1[1]); w.w = cvt_pk_bf16(v1[2], v1[3]);
                    *(u32x4*)(rowp + bj * HALF) = w; } }
    }
};
struct EpiSwiglu {
    static constexpr bool PERM = true;
    bf16_t* O; int ldc;
    __device__ __forceinline__ void operator()(const f32x4 (&acc)[2][2][4][2], const Unit& u, int wr, int wc, int fr, int fq) const {
        const int row0 = u.pm * BM + wr * 64 + fr, col0 = u.pn * HALF + wc * 32 + 8 * fq;
#pragma unroll
        for (int ai = 0; ai < 2; ++ai)
#pragma unroll
            for (int m = 0; m < 4; ++m) { bf16_t* rowp = O + (size_t)(row0 + ai * HALF + m * 16) * ldc + col0;
                float v[8];
#pragma unroll
                for (int n = 0; n < 2; ++n)
#pragma unroll
                    for (int j = 0; j < 4; ++j) { const float g = acc[ai][0][m][n][j], up = acc[ai][1][m][n][j];
                        v[n * 4 + j] = g * __builtin_amdgcn_rcpf(1.0f + __builtin_amdgcn_exp2f(-g * LOG2E)) * up; }
                u32x4 w; w.x = cvt_pk_bf16(v[0], v[1]); w.y = cvt_pk_bf16(v[2], v[3]); w.z = cvt_pk_bf16(v[4], v[5]); w.w = cvt_pk_bf16(v[6], v[7]);
                *(u32x4*)rowp = w; }
    }
};
constexpr int XST = 2 * DM;
template <bool INF32, bool NORM>
struct EpiRes {
    static constexpr bool PERM = true;
    const void* xin_l; const void* xin_c; bf16_t* xout_l; bf16_t* xout_c; const float* ga_base;
    const float* gn; const float* sc_base; bf16_t* XS; float* SS;
    __device__ __forceinline__ void operator()(const f32x4 (&acc)[2][2][4][2], const Unit& u, int wr, int wc, int fr, int fq) const {
        const int b = u.pm / 17, j = u.pm - 17 * b, mrow = j == 0 ? 8 : b;
        const float* ga = ga_base + mrow * 6144; const float* sc = sc_base + mrow * 6144;
        const size_t rbase = j == 0 ? (size_t)b * CTX : (size_t)b * SEQ + (size_t)(j - 1) * 256;
        const float* xif = (const float*)(j == 0 ? xin_c : xin_l) + rbase * DM; const bf16_t* xib = (const bf16_t*)(j == 0 ? xin_c : xin_l) + rbase * XST; bf16_t* xo = (j == 0 ? xout_c : xout_l) + rbase * XST;
        const int row0 = wr * 64 + fr, col0 = u.pn * BM + wc * 32 + 8 * fq;
        f32x4 gv[2][2], gs[2][2];
#pragma unroll
        for (int bj = 0; bj < 2; ++bj)
#pragma unroll
            for (int n = 0; n < 2; ++n) { const int c = col0 + bj * HALF + n * 4; gv[bj][n] = *(const f32x4*)(ga + c); if constexpr (NORM) gs[bj][n] = *(const f32x4*)(gn + c) * (*(const f32x4*)(sc + c) + 1.0f); }
        bf16_t* xs = XS + (size_t)u.pm * BM * DM; float* ssp = SS + (size_t)(u.pn * 4 + wc) * NROW + u.pm * BM;
#pragma unroll
        for (int ai = 0; ai < 2; ++ai)
#pragma unroll
            for (int mh = 0; mh < 2; ++mh) {
                f32x4 xv[2][2][2];
#pragma unroll
                for (int m2 = 0; m2 < 2; ++m2) { const int rt_ = row0 + ai * HALF + (mh * 2 + m2) * 16;
#pragma unroll
                    for (int bj = 0; bj < 2; ++bj) {
                        if constexpr (INF32) { xv[m2][bj][0] = *(const f32x4*)(xif + (size_t)rt_ * DM + col0 + bj * HALF); xv[m2][bj][1] = *(const f32x4*)(xif + (size_t)rt_ * DM + col0 + bj * HALF + 4); }
                        else { const u32x4 q = *(const u32x4*)(xib + (size_t)rt_ * XST + col0 + bj * HALF);
                            xv[m2][bj][0] = (f32x4){__uint_as_float(q.x << 16), __uint_as_float(q.x & 0xffff0000u), __uint_as_float(q.y << 16), __uint_as_float(q.y & 0xffff0000u)};
                            xv[m2][bj][1] = (f32x4){__uint_as_float(q.z << 16), __uint_as_float(q.z & 0xffff0000u), __uint_as_float(q.w << 16), __uint_as_float(q.w & 0xffff0000u)}; } } }
#pragma unroll
                for (int m2 = 0; m2 < 2; ++m2) { const int rt_ = row0 + ai * HALF + (mh * 2 + m2) * 16; float ss = 0.f;
#pragma unroll
                    for (int bj = 0; bj < 2; ++bj) { f32x4 y[2];
#pragma unroll
                        for (int n = 0; n < 2; ++n) { y[n] = xv[m2][bj][n] + gv[bj][n] * acc[ai][bj][mh * 2 + m2][n];
                            ss += (y[n][0] * y[n][0] + y[n][1] * y[n][1]) + (y[n][2] * y[n][2] + y[n][3] * y[n][3]); }
                        u32x4 w; w.x = cvt_pk_bf16(y[0][0], y[0][1]); w.y = cvt_pk_bf16(y[0][2], y[0][3]); w.z = cvt_pk_bf16(y[1][0], y[1][1]); w.w = cvt_pk_bf16(y[1][2], y[1][3]);
                        *(u32x4*)(xo + (size_t)rt_ * XST + col0 + bj * HALF) = w;
                        if constexpr (NORM) { y[0] = y[0] * gs[bj][0]; y[1] = y[1] * gs[bj][1];
                            u32x4 w2; w2.x = cvt_pk_bf16(y[0][0], y[0][1]); w2.y = cvt_pk_bf16(y[0][2], y[0][3]); w2.z = cvt_pk_bf16(y[1][0], y[1][1]); w2.w = cvt_pk_bf16(y[1][2], y[1][3]);
                            *(u32x4*)(xs + (size_t)rt_ * DM + col0 + bj * HALF) = w2; } }
                    if constexpr (NORM) { ss += __shfl_xor(ss, 16); ss += __shfl_xor(ss, 32); if (fq == 0) ssp[rt_] = ss; } }
                asm volatile("" ::: "memory"); }
    }
};
template <bool NORM>
struct EpiProj {
    static constexpr bool PERM = true;
    bf16_t* O; int ldc; const PG8_LAS float* tb; const float* rope;
    __device__ __forceinline__ void operator()(const f32x4 (&acc)[2][2][4][2], const Unit& u, int wr, int wc, int fr, int fq) const {
        const int b = u.pm / 17, jt = u.pm - 17 * b; const bool rot = jt != 0 && u.pn >= ZDQ / 256 && u.pn < ZDV / 256; const int axis = wc & 1;
        const int row0 = u.pm * BM + wr * 64 + fr, col0 = u.pn * BM + wc * 32 + 8 * fq; const PG8_LAS float* rp = tb + u.sl * 512 + wr * 64 + fr; const PG8_LAS float* sp = tb + u.sl * 512 + 256 + wc * 32 + 8 * fq;
        f32x4 s[2][2];
        if constexpr (NORM) {
#pragma unroll
            for (int bj = 0; bj < 2; ++bj)
#pragma unroll
                for (int n = 0; n < 2; ++n) s[bj][n] = *(const PG8_LAS f32x4*)(sp + bj * HALF + n * 4); }
#pragma unroll
        for (int ai = 0; ai < 2; ++ai)
#pragma unroll
            for (int m = 0; m < 4; ++m) { bf16_t* rowp = O + (size_t)(row0 + ai * HALF + m * 16) * ldc + col0; float r = 1.0f; if constexpr (NORM) r = rp[ai * HALF + m * 16];
                f32x4 c01 = {1.f, 0.f, 1.f, 0.f}, c23 = {1.f, 0.f, 1.f, 0.f};
                if (rot) { const int pos = axis ? 16 * m + fr : (jt - 1) * 4 + 2 * ai + wr; const float* cp = rope + (pos * 16 + 4 * fq) * 2; c01 = *(const f32x4*)cp; c23 = *(const f32x4*)(cp + 4); }
#pragma unroll
                for (int bj = 0; bj < 2; ++bj) { f32x4 v0 = acc[ai][bj][m][0], v1 = acc[ai][bj][m][1];
                    if constexpr (NORM) { v0 = v0 * r + s[bj][0]; v1 = v1 * r + s[bj][1]; }
                    if (rot) { f32x4 o0, o1;
                        o0[0] = v0[0] * c01[0] - v1[0] * c01[1]; o1[0] = v0[0] * c01[1] + v1[0] * c01[0]; o0[1] = v0[1] * c01[2] - v1[1] * c01[3]; o1[1] = v0[1] * c01[3] + v1[1] * c01[2];
                        o0[2] = v0[2] * c23[0] - v1[2] * c23[1]; o1[2] = v0[2] * c23[1] + v1[2] * c23[0]; o0[3] = v0[3] * c23[2] - v1[3] * c23[3]; o1[3] = v0[3] * c23[3] + v1[3] * c23[2];
                        v0 = o0; v1 = o1; }
                    u32x4 w; w.x = cvt_pk_bf16(v0[0], v0[1]); w.y = cvt_pk_bf16(v0[2], v0[3]); w.z = cvt_pk_bf16(v1[0], v1[1]); w.w = cvt_pk_bf16(v1[2], v1[3]);
                    *(u32x4*)(rowp + bj * HALF) = w; } }
    }
};
struct EpiSwigluN {
    static constexpr bool PERM = true;
    bf16_t* O; int ldc; const PG8_LAS float* tb;
    __device__ __forceinline__ void operator()(const f32x4 (&acc)[2][2][4][2], const Unit& u, int wr, int wc, int fr, int fq) const {
        const int row0 = u.pm * BM + wr * 64 + fr, col0 = u.pn * HALF + wc * 32 + 8 * fq; const PG8_LAS float* rp = tb + u.sl * 512 + wr * 64 + fr; const PG8_LAS float* sp = tb + u.sl * 512 + 256 + wc * 32 + 8 * fq;
        f32x4 s[2][2];
#pragma unroll
        for (int bj = 0; bj < 2; ++bj)
#pragma unroll
            for (int n = 0; n < 2; ++n) s[bj][n] = *(const PG8_LAS f32x4*)(sp + bj * HALF + n * 4);
#pragma unroll
        for (int ai = 0; ai < 2; ++ai)
#pragma unroll
            for (int m = 0; m < 4; ++m) { bf16_t* rowp = O + (size_t)(row0 + ai * HALF + m * 16) * ldc + col0; const float r = rp[ai * HALF + m * 16];
                float v[8];
#pragma unroll
                for (int n = 0; n < 2; ++n)
#pragma unroll
                    for (int j = 0; j < 4; ++j) { const float g = acc[ai][0][m][n][j] * r + s[0][n][j], up = acc[ai][1][m][n][j] * r + s[1][n][j];
                        v[n * 4 + j] = g * __builtin_amdgcn_rcpf(1.0f + __builtin_amdgcn_exp2f(-g * LOG2E)) * up; }
                u32x4 w; w.x = cvt_pk_bf16(v[0], v[1]); w.y = cvt_pk_bf16(v[2], v[3]); w.z = cvt_pk_bf16(v[4], v[5]); w.w = cvt_pk_bf16(v[6], v[7]);
                *(u32x4*)rowp = w; }
    }
};
template <class Sched>
__device__ __forceinline__ void stage_norm_tables(PG8_LAS unsigned char* lds, const float* SS, const float* sw, int swld, const Sched& S) {
    PG8_LAS float* tb = (PG8_LAS float*)(lds + GROWS_OFF); const int row = threadIdx.x & 255, half = threadIdx.x >> 8;
    Unit u0; if (!S.next(0, u0)) return;
    float part[GROWS_MAX], sv[GROWS_MAX];
#pragma unroll
    for (int i = 0; i < GROWS_MAX; ++i) { Unit u; if (!S.next(i, u)) u = u0;
        const float* sp = SS + (size_t)(half * 8) * NROW + u.pm * BM + row; float s = 0.f;
#pragma unroll
        for (int k = 0; k < 8; ++k) s += sp[(size_t)k * NROW];
        part[i] = s; const int b = u.pm / 17, mrow = (u.pm - 17 * b) == 0 ? 8 : b; sv[i] = sw[(size_t)mrow * swld + u.pn * BM + row]; }
    if (half) {
#pragma unroll
        for (int i = 0; i < GROWS_MAX; ++i) { tb[i * 512 + row] = part[i]; tb[i * 512 + 256 + row] = sv[i]; } }
    __syncthreads();
    if (!half) {
#pragma unroll
        for (int i = 0; i < GROWS_MAX; ++i) tb[i * 512 + row] = rsqrtf((tb[i * 512 + row] + part[i]) * (1.0f / DM) + RMS_EPS); }
    __syncthreads();
}

template <class Sched>
__device__ __forceinline__ void stage_gather_rows(PG8_LAS unsigned char* lds, const int* rows, const Sched& S) {
    PG8_LAS int* rl = (PG8_LAS int*)(lds + GROWS_OFF); Unit u;
    for (int i = 0; i < GROWS_MAX && S.next(i, u); ++i) if (threadIdx.x < 256) rl[i * 256 + threadIdx.x] = rows[u.ga * 256 + threadIdx.x];
    __syncthreads();
}
template <class Epi, class Sched, bool ALIGN_EPI, bool GATHER>
__device__ __forceinline__ void gemm_phase(PG8_LAS unsigned char* lds, const Gemm g, const Sched& S, const Epi& E) {
    const int tid = threadIdx.x, wid = __builtin_amdgcn_readfirstlane(tid >> 6), lane = tid & 63, wr = wid >> 2, wc = wid & 3, fr = lane & 15, fq = lane >> 4;
    const int K = g.K, nt = (g.Kloop ? g.Kloop : K) / BK;
    unsigned voffA[2], voffB[2];
#pragma unroll
    for (int i = 0; i < 2; ++i) { int R, C; stage_rc(tid * 16 + i * 8192, R, C); const int Rb = Epi::PERM ? ((R & ~31) + perm32(R & 31)) : R;
        voffA[i] = (unsigned)(R * K + C) * 2u; voffB[i] = (unsigned)(Rb * K + C) * 2u; }
    const size_t kstep = (size_t)(BK * 2);
    const size_t hstep = (size_t)HALF * K * 2;
    const size_t tstep = 2 * hstep;
    const unsigned ldsw = (unsigned)wid * 1024u;
    const int aoff = lds_byte(wr * 64 + fr, fq * 8), boff = lds_byte(wc * 32 + fr, fq * 8);
#define PG8_SA(b, h) (((b) * 2 + (h)) * HTB)
#define PG8_SB(b, h) ((4 + (b) * 2 + (h)) * HTB)
#define PG8_STAGE(bufoff, gbase, voff) do { _Pragma("unroll") for (int _i = 0; _i < 2; ++_i) \
        __builtin_amdgcn_global_load_lds((const unsigned*)((const char*)(gbase) + (voff)[_i]), (PG8_LAS unsigned*)(lds + (bufoff) + ldsw + _i * 8192), 16, 0, 0); } while (0)
#define PG8_STAGE_A(bufoff, kp, h, nx) do { if constexpr (GATHER) { unsigned _g[2] = { (nx) ? gN[h][0] : gA[h][0], (nx) ? gN[h][1] : gA[h][1] }; PG8_STAGE(bufoff, kp, _g); } \
        else { PG8_STAGE(bufoff, (kp) + (h) * hstep, voffA); } } while (0)
#define PG8_LDA(dst, b, h) do { _Pragma("unroll") for (int m = 0; m < 4; ++m) _Pragma("unroll") for (int k = 0; k < 2; ++k) dst[m][k] = *(const PG8_LAS bf16x8*)(lds + PG8_SA(b, h) + aoff + m * 2048 + k * 1024); } while (0)
#define PG8_LDB(dst, b, h) do { _Pragma("unroll") for (int n = 0; n < 2; ++n) _Pragma("unroll") for (int k = 0; k < 2; ++k) dst[n][k] = *(const PG8_LAS bf16x8*)(lds + PG8_SB(b, h) + boff + n * 2048 + k * 1024); } while (0)
#define PG8_MMA(ai, bj, At, Bt) do { __builtin_amdgcn_s_setprio(1); _Pragma("unroll") for (int m = 0; m < 4; ++m) _Pragma("unroll") for (int n = 0; n < 2; ++n) _Pragma("unroll") for (int k = 0; k < 2; ++k) \
        acc[ai][bj][m][n] = __builtin_amdgcn_mfma_f32_16x16x32_bf16(Bt[n][k], At[m][k], acc[ai][bj][m][n], 0, 0, 0); __builtin_amdgcn_s_setprio(0); } while (0)
#define PG8_WAIT_V(n) asm volatile("s_waitcnt vmcnt(" #n ")" ::: "memory")
#define PG8_WAIT_L(n) asm volatile("s_waitcnt lgkmcnt(" #n ")" ::: "memory")
#define PG8_BAR __builtin_amdgcn_s_barrier()
#define PG8_SCHED __builtin_amdgcn_sched_barrier(0)
#define PG8_GLOAD(dst, slot) do { const PG8_LAS int* rl_ = (const PG8_LAS int*)(lds + GROWS_OFF) + (slot) * 256; _Pragma("unroll") for (int _h = 0; _h < 2; ++_h) _Pragma("unroll") for (int _i = 0; _i < 2; ++_i) { int R_, C_; stage_rc(tid * 16 + _i * 8192, R_, C_); \
        dst[_h][_i] = ((unsigned)rl_[_h * 128 + R_] * (unsigned)K + (unsigned)C_) * 2u; } } while (0)
    Unit cur, nxt; int ui = 0;
    if (!S.next(0, cur)) return;
    f32x4 acc[2][2][4][2];
#pragma unroll
    for (int a = 0; a < 2; ++a)
#pragma unroll
        for (int b = 0; b < 2; ++b)
#pragma unroll
            for (int m = 0; m < 4; ++m)
#pragma unroll
                for (int n = 0; n < 2; ++n) acc[a][b][m][n] = (f32x4){0.f, 0.f, 0.f, 0.f};
    bf16x8 At[4][2], B0[2][2], B1[2][2];
    unsigned gA[2][2], gN[2][2];
    if constexpr (GATHER) { PG8_GLOAD(gA, 0); } else { gA[0][0] = gA[0][1] = gA[1][0] = gA[1][1] = 0u; }
#pragma unroll
    for (int h = 0; h < 2; ++h)
#pragma unroll
        for (int i = 0; i < 2; ++i) gN[h][i] = gA[h][i];
    const char* cA = GATHER ? (const char*)g.A : (const char*)g.A + (size_t)cur.pm * tstep + cur.ko; const char* cB = (const char*)g.Bt + cur.bo + cur.ko;
    PG8_STAGE(PG8_SB(0, 0), cB, voffB); PG8_STAGE(PG8_SB(0, 1), cB + hstep, voffB); PG8_STAGE_A(PG8_SA(0, 0), cA, 0, false); PG8_STAGE_A(PG8_SA(0, 1), cA, 1, false);
    if (wr == 1) PG8_BAR;
    PG8_WAIT_V(2); PG8_BAR;
    PG8_STAGE(PG8_SB(1, 0), cB + kstep, voffB); PG8_STAGE_A(PG8_SA(1, 0), cA + kstep, 0, false); PG8_STAGE(PG8_SB(1, 1), cB + hstep + kstep, voffB);
    PG8_WAIT_V(6); PG8_BAR;
    for (;;) {
        const bool has_next = S.next(ui + 1, nxt);
        if constexpr (GATHER) { if (has_next) { PG8_GLOAD(gN, ui + 1); } }
        const char* nA = GATHER ? cA : (has_next ? (const char*)g.A + (size_t)nxt.pm * tstep + nxt.ko : cA); const char* nB = has_next ? (const char*)g.Bt + nxt.bo + nxt.ko : cB;
        for (int t = 0; t < nt; t += 2) {
            const bool last = (t == nt - 2);
            const char* a1 = cA + (size_t)(t + 1) * kstep;
            const char* a2 = last ? nA : cA + (size_t)(t + 2) * kstep; const char* b2 = last ? nB : cB + (size_t)(t + 2) * kstep;
            const char* a3 = a2 + kstep; const char* b3 = b2 + kstep;
            PG8_LDB(B0, 0, 0); PG8_LDB(B1, 0, 1); PG8_SCHED; PG8_LDA(At, 0, 0); PG8_STAGE_A(PG8_SA(1, 1), a1, 1, false);
            PG8_WAIT_V(8); PG8_WAIT_L(0); PG8_BAR; PG8_MMA(0, 0, At, B0); PG8_MMA(0, 1, At, B1); PG8_BAR; PG8_SCHED;
            PG8_LDA(At, 0, 1); PG8_STAGE(PG8_SB(0, 0), b2, voffB); PG8_STAGE(PG8_SB(0, 1), b2 + hstep, voffB); PG8_STAGE_A(PG8_SA(0, 0), a2, 0, last);
            PG8_WAIT_V(8); PG8_WAIT_L(0); PG8_BAR; PG8_MMA(1, 0, At, B0); PG8_MMA(1, 1, At, B1); PG8_BAR; PG8_SCHED;
            PG8_LDB(B0, 1, 0); PG8_LDB(B1, 1, 1); PG8_SCHED; PG8_LDA(At, 1, 0); PG8_STAGE_A(PG8_SA(0, 1), a2, 1, last);
            PG8_WAIT_V(8); PG8_WAIT_L(0); PG8_BAR; PG8_MMA(0, 0, At, B0); PG8_MMA(0, 1, At, B1); PG8_BAR; PG8_SCHED;
            PG8_LDA(At, 1, 1); PG8_STAGE(PG8_SB(1, 0), b3, voffB); PG8_STAGE(PG8_SB(1, 1), b3 + hstep, voffB); PG8_STAGE_A(PG8_SA(1, 0), a3, 0, last);
            PG8_WAIT_V(8); PG8_WAIT_L(0); PG8_BAR; PG8_MMA(1, 0, At, B0); PG8_MMA(1, 1, At, B1); PG8_BAR; PG8_SCHED;
        }
        if constexpr (ALIGN_EPI) { if (wr == 0) PG8_BAR; }
        E(acc, cur, wr, wc, fr, fq);
        if (!has_next) break;
#pragma unroll
        for (int a = 0; a < 2; ++a)
#pragma unroll
            for (int b = 0; b < 2; ++b)
#pragma unroll
                for (int m = 0; m < 4; ++m)
#pragma unroll
                    for (int n = 0; n < 2; ++n) acc[a][b][m][n] = (f32x4){0.f, 0.f, 0.f, 0.f};
        cur = nxt; cA = nA; cB = nB; ++ui;
#pragma unroll
        for (int h = 0; h < 2; ++h)
#pragma unroll
            for (int i = 0; i < 2; ++i) gA[h][i] = gN[h][i];
        if constexpr (ALIGN_EPI) { if (wr == 1) PG8_BAR; }
    }
    PG8_WAIT_V(0);
    if constexpr (!ALIGN_EPI) { if (wr == 0) PG8_BAR; }
    PG8_BAR;
#undef PG8_SA
#undef PG8_SB
#undef PG8_STAGE
#undef PG8_STAGE_A
#undef PG8_LDA
#undef PG8_LDB
#undef PG8_MMA
#undef PG8_WAIT_V
#undef PG8_WAIT_L
#undef PG8_BAR
#undef PG8_SCHED
#undef PG8_GLOAD
}
}

#define XB_TMO      128
#define XB_XCNT(j)  (256  + 64 * (j))
#define XB_XSUB(j)  (1280 + 64 * (j))
#define XB_XGEN(j)  (2304 + 64 * (j))
#define XB_TOP      3328
#define XB_TOPGEN   3392
#define XCD_BAR_WORDS 3456
#define XB_SPIN_CAP (1u << 18)
__device__ __forceinline__ unsigned xb_ld(unsigned* p)              { return __hip_atomic_load(p, __ATOMIC_RELAXED, __HIP_MEMORY_SCOPE_AGENT); }
__device__ __forceinline__ unsigned xb_add(unsigned* p, unsigned v) { return __hip_atomic_fetch_add(p, v, __ATOMIC_RELAXED, __HIP_MEMORY_SCOPE_AGENT); }
__device__ __forceinline__ unsigned xb_xcc_id() { return (unsigned)__builtin_amdgcn_s_getreg((3 << 11) | 20) & 0xFu; }
#define XB_SPIN(cond, bar) do { unsigned _sp = 0; while (cond) { __builtin_amdgcn_s_sleep(1); \
    if ((++_sp & 255u) == 0u) { if (xb_ld(&(bar)[XB_TMO])) break; if (_sp > XB_SPIN_CAP) { atomicAdd(&(bar)[XB_TMO], 1u); break; } } } } while (0)
struct XcdBarrier { unsigned* bar; unsigned x; volatile LAS unsigned* st; };
__device__ __forceinline__ XcdBarrier xcd_barrier_post(unsigned* bar, volatile LAS unsigned* st) {
    XcdBarrier b; b.bar = bar; b.x = xb_xcc_id(); b.st = st;
    if (threadIdx.x == 0) (void)xb_add(&bar[XB_XCNT(b.x)], 1u);
    return b;
}
__device__ __forceinline__ void xcd_barrier_complete(unsigned* bar, unsigned x, unsigned& nloc, unsigned& nx) {
    const unsigned G = gridDim.x * gridDim.y * gridDim.z;
    unsigned sum, cnt, mine, sp = 0u;
    for (;;) {
        sum = 0u; cnt = 0u; mine = 0u;
#pragma unroll
        for (unsigned j = 0; j < 16; ++j) { const unsigned c = xb_ld(&bar[XB_XCNT(j)]); sum += c; cnt += (c > 0u) ? 1u : 0u; mine = (j == x) ? c : mine; }
        if (sum == G) break;
        __builtin_amdgcn_s_sleep(1);
        if ((++sp & 255u) == 0u) { if (xb_ld(&bar[XB_TMO])) break; if (sp > XB_SPIN_CAP) { atomicAdd(&bar[XB_TMO], 1u); break; } }
    }
    nloc = mine > 0u ? mine : 1u; nx = cnt > 0u ? cnt : 1u;
}
__device__ __forceinline__ void xcd_barrier(const XcdBarrier& b) {
    asm volatile("s_waitcnt vmcnt(0)" ::: "memory");
    __syncthreads();
    if (threadIdx.x == 0) {
        unsigned* bar = b.bar;
        __builtin_amdgcn_s_waitcnt(0);
        unsigned nloc = b.st[0], nx = b.st[1];
        if (nloc == 0u) { xcd_barrier_complete(bar, b.x, nloc, nx); b.st[0] = nloc; b.st[1] = nx; }
        const unsigned old = xb_add(&bar[XB_XSUB(b.x)], 1u);
        const unsigned gen = old / nloc;
        if (old + 1u == (gen + 1u) * nloc) {
            __builtin_amdgcn_fence(__ATOMIC_RELEASE, "agent");
            asm volatile("s_waitcnt vmcnt(0)" ::: "memory");
            const unsigned og = xb_add(&bar[XB_TOP], 1u);
            const unsigned tg = og / nx;
            if (og + 1u == (tg + 1u) * nx) xb_add(&bar[XB_TOPGEN], 1u);
            else XB_SPIN(xb_ld(&bar[XB_TOPGEN]) == tg, bar);
            __builtin_amdgcn_fence(__ATOMIC_ACQUIRE, "agent");
            xb_add(&bar[XB_XGEN(b.x)], 1u);
            asm volatile("s_waitcnt vmcnt(0)" ::: "memory");
        } else {
            XB_SPIN(xb_ld(&bar[XB_XGEN(b.x)]) == gen, bar);
            __builtin_amdgcn_fence(__ATOMIC_ACQUIRE, "agent");
            asm volatile("s_waitcnt vmcnt(0)" ::: "memory");
        }
    }
    __syncthreads();
}
struct Args { const float* in[24]; float* out; unsigned char* ws; int ph_lo, ph_hi; };
typedef __attribute__((address_space(4))) const Args CArgs;
struct Frame {
    LAS unsigned char* lds;
    int tid, lane, wave, G, gw, ngw;
    CArgs* ap;
    GAS float* out; GAS unsigned char* ws;
};
#define GIN(i) ((const float*)(const GAS float*)(F.ap->in[i]))
#define IN_X 0
#define IN_C 1
#define IN_CTX 2
#define IN_CCTX 3
#define IN_WMOD 4
#define IN_BMOD 5
#define IN_GN1 6
#define IN_GN2 7
#define IN_WIN 8
#define IN_WDEC 9
#define IN_BDEC 10
#define IN_GGLA 11
#define IN_LAM 12
#define IN_GDIFF 13
#define IN_RPB 14
#define IN_WOUT 15
#define IN_WG 16
#define IN_WU 17
#define IN_WD 18
#define IN_WR 19
#define IN_MG 20
#define IN_MU 21
#define IN_MD 22
#define IN_GF 23

struct TrItem { const float* W; bf16* WT; int K, Nsrc, k0, n0, r0; float scale; int perm; };
__device__ __forceinline__ void tr_load(const TrItem& t, float (&tv)[32], int lane) {
#pragma unroll
    for (int i = 0; i < 32; ++i) tv[i] = __builtin_nontemporal_load(&t.W[(size_t)(t.k0 + 2 * i + (lane >> 5)) * t.Nsrc + t.n0 + (lane & 31)]);
}
__device__ __forceinline__ void tr_finish(const TrItem& t, const float (&tv)[32], LAS float* scr, int lane) {
#pragma unroll
    for (int i = 0; i < 32; ++i) scr[(2 * i + (lane >> 5)) * 33 + (lane & 31)] = tv[i];
    asm volatile("s_waitcnt lgkmcnt(0)" ::: "memory");
    const int c = lane & 7;
#pragma unroll
    for (int j = 0; j < 4; ++j) { const int n = (lane >> 3) + 8 * j; const LAS float* s = scr + (8 * c) * 33 + n; const float sc = t.scale;
        u32x4 o; o.x = pk2(s[0 * 33] * sc, s[1 * 33] * sc); o.y = pk2(s[2 * 33] * sc, s[3 * 33] * sc); o.z = pk2(s[4 * 33] * sc, s[5 * 33] * sc); o.w = pk2(s[6 * 33] * sc, s[7 * 33] * sc);
        const int no = t.perm ? (8 * ((n & 15) >> 2) + (n & 3) + ((n >> 4) << 2)) : n;
        *(u32x4*)(t.WT + (size_t)(t.r0 + no) * t.K + t.k0 + 8 * c) = o; }
    asm volatile("s_waitcnt lgkmcnt(0)" ::: "memory");
}
__device__ __forceinline__ void tr_item(const float* W, int K, int Nsrc, int k0, int n0, bf16* WT, int r0, float scale, LAS float* scr, int lane) {
    const TrItem t{W, WT, K, Nsrc, k0, n0, r0, scale, 0}; float tv[32]; tr_load(t, tv, lane); tr_finish(t, tv, scr, lane);
}
__device__ __forceinline__ TrItem ffn_tr_desc(const float* wg, const float* wu, const float* wd, int FF, bf16* gu_t, bf16* dn_t, int it) {
    const int nb = FF / 32, per = 16 * nb;
    if (it < 2 * per) { const bool up = it >= per; const int r = up ? it - per : it; const int kb = r / nb, n0 = (r % nb) * 32;
        return TrItem{up ? wu : wg, gu_t, DM, FF, kb * 64, n0, 256 * (n0 >> 7) + (n0 & 127) + (up ? 128 : 0), 1.0f, 0}; }
    const int r = it - 2 * per; const int kb = r / 32, n0 = (r % 32) * 32; return TrItem{wd, dn_t, FF, DM, kb * 64, n0, n0, 1.0f, 0};
}
__device__ __forceinline__ void ffn_tr_item(const float* wg, const float* wu, const float* wd, int FF, bf16* gu_t, bf16* dn_t, int it, LAS float* scr, int lane) {
    const TrItem t = ffn_tr_desc(wg, wu, wd, FF, gu_t, dn_t, it); float tv[32]; tr_load(t, tv, lane); tr_finish(t, tv, scr, lane);
}
__device__ __forceinline__ TrItem pro_desc(const Frame& F, int it) {
    constexpr int N_IN = 1536, N_OUT = 512;
    if (it < 2 * (N_IN + N_OUT)) {
        const int l = it / (N_IN + N_OUT), r = it % (N_IN + N_OUT);
        if (r < N_IN) { const int kb = r / 96, nbk = r % 96, r0 = nbk * 32, n0 = r0 < 768 ? r0 : r0 + 32;
            const float sc = r0 < 128 ? 0.17677669529663687f : ((r0 >= ZDQ && r0 < ZDK) || (r0 >= ZNQ && r0 < ZNK)) ? QSCALE : 1.0f;
            return TrItem{GIN(IN_WIN) + (size_t)l * 1024 * 3104, (bf16*)(F.ws + (l ? W_IN1 : W_IN0)), DM, 3104, kb * 64, n0, r0, sc, (r0 >= ZDQ && r0 < ZDV) ? 1 : 0}; }
        const int q = r - N_IN, kb = q / 32, n0 = (q % 32) * 32;
        return TrItem{GIN(IN_WOUT) + (size_t)l * 1024 * 1024, (bf16*)(F.ws + (l ? W_OUT1 : W_OUT0)), DM, DM, kb * 64, n0, n0, 1.0f, 0};
    }
    return ffn_tr_desc(GIN(IN_WG), GIN(IN_WU), GIN(IN_WD), FFD, (bf16*)(F.ws + W_GU), (bf16*)(F.ws + W_DN), it - 2 * (N_IN + N_OUT));
}
constexpr int PRO_NTR = 2 * (1536 + 512) + 3 * 16 * (FFD / 32), PRO_NMOD = 2 * 96, PRO_NLG = 256;
__device__ __forceinline__ int pro_split(const Frame& F) { if (F.G < PRO_NMOD + 16) return PRO_NTR; const int s = 3 * (F.ngw - 8 * PRO_NMOD) + 8 * PRO_NMOD; return s < PRO_NTR ? s : PRO_NTR; }
__device__ __forceinline__ void tr_range(const Frame& F, LAS float* scr, int it, int stride, int lim) {
    if (it >= lim) return;
    float ta[32], tb2[32]; TrItem da = pro_desc(F, it), db = da; tr_load(da, ta, F.lane);
    for (;;) {
        const bool nb_ = it + stride < lim; if (nb_) { db = pro_desc(F, it + stride); tr_load(db, tb2, F.lane); }
        tr_finish(da, ta, scr, F.lane); it += stride; if (!nb_) break;
        const bool na_ = it + stride < lim; if (na_) { da = pro_desc(F, it + stride); tr_load(da, ta, F.lane); }
        tr_finish(db, tb2, scr, F.lane); it += stride; if (!na_) break;
    }
}
__device__ __forceinline__ void phase_transposes_rest(const Frame& F) {
    LAS float* scr = (LAS float*)(F.lds + 40960 + F.wave * 8704); const int s = pro_split(F);
    tr_range(F, scr, s + F.gw, F.ngw, PRO_NTR);
}
__device__ __forceinline__ void phase_prologue(const Frame& F) {
    LAS float* scr = (LAS float*)(F.lds + 40960 + F.wave * 8704);
    LAS float* red = (LAS float*)(F.lds + 112640);
    float* MOD = (float*)(F.ws + WS_SM);
    if ((int)blockIdx.x < PRO_NMOD) {
        for (int item = blockIdx.x; item < PRO_NMOD; item += F.G) {
            const int l = item / 96, cg = item % 96, n = cg * 64 + F.lane, k0 = F.wave * 128;
            const float* w = GIN(IN_WMOD) + ((size_t)l * 1024 + k0) * 6144 + n;
            float sc0[9], sc1[9], acc[9];
#pragma unroll
            for (int r = 0; r < 9; ++r) { const float* cv = r < 8 ? GIN(IN_C) + r * 1024 : GIN(IN_CCTX); sc0[r] = silu_f(cv[k0 + F.lane]); sc1[r] = silu_f(cv[k0 + 64 + F.lane]); acc[r] = 0.f; }
#pragma nounroll
            for (int kb = 0; kb < 128; kb += 32) { float wv[32]; int scs[9];
#pragma unroll
                for (int k = 0; k < 32; ++k) wv[k] = __builtin_nontemporal_load(&w[(size_t)(kb + k) * 6144]);
#pragma unroll
                for (int r = 0; r < 9; ++r) scs[r] = __float_as_int((kb & 64) ? sc1[r] : sc0[r]);
                const int lb = kb & 32;
#pragma unroll
                for (int k = 0; k < 32; ++k)
#pragma unroll
                    for (int r = 0; r < 9; ++r) acc[r] += __int_as_float(__builtin_amdgcn_readlane(scs[r], lb + k)) * wv[k]; }
#pragma unroll
            for (int r = 0; r < 9; ++r) red[(F.wave * 9 + r) * 64 + F.lane] = acc[r];
            __syncthreads();
            for (int t = F.tid; t < 9 * 64; t += 512) { const int r = t >> 6, ln = t & 63; float sum = GIN(IN_BMOD)[l * 6144 + cg * 64 + ln];
#pragma unroll
                for (int wv_ = 0; wv_ < 8; ++wv_) sum += red[(wv_ * 9 + r) * 64 + ln];
                MOD[((size_t)l * 9 + r) * 6144 + cg * 64 + ln] = sum; }
            __syncthreads();
        }
    }
    { const int lgw = F.ngw - 1 - F.gw;
      for (int it = lgw; it < PRO_NLG; it += F.ngw) {
            const int l = it >> 7, kb = (it >> 3) & 15, dir = (it >> 2) & 1, jq = it & 3, k = kb * 64 + F.lane;
            const float* wi = GIN(IN_WIN) + ((size_t)l * 1024 + k) * 3104 + 768 + dir * 16;
            const f32x4 z0 = *(const f32x4*)wi, z1 = *(const f32x4*)(wi + 4), z2 = *(const f32x4*)(wi + 8), z3 = *(const f32x4*)(wi + 12);
            const float zr[16] = {z0.x, z0.y, z0.z, z0.w, z1.x, z1.y, z1.z, z1.w, z2.x, z2.y, z2.z, z2.w, z3.x, z3.y, z3.z, z3.w};
            const float* wup = GIN(IN_WDEC) + ((size_t)l * 2 + dir) * 16 * 128 + jq * 32 + (F.lane & 31);
            int wu[16];
#pragma unroll
            for (int r = 0; r < 16; ++r) wu[r] = __float_as_int(wup[r * 128]);
            bf16* dst = (bf16*)(F.ws + (l ? W_IN1 : W_IN0)) + (size_t)(ZLG + dir * 128 + jq * 32) * DM + k;
#pragma unroll
            for (int j = 0; j < 32; ++j) { float s = 0.f;
#pragma unroll
                for (int r = 0; r < 16; ++r) s += zr[r] * __int_as_float(__builtin_amdgcn_readlane(wu[r], j));
                dst[(size_t)j * DM] = (bf16)f2bf(s); }
      } }
    { int it, stride, lim;
      if (F.G < PRO_NMOD + 16) { it = F.gw; stride = F.ngw; lim = PRO_NTR; }
      else if ((int)blockIdx.x >= PRO_NMOD) { it = F.gw - 8 * PRO_NMOD; stride = F.ngw - 8 * PRO_NMOD; lim = 3 * stride; }
      else { it = 3 * (F.ngw - 8 * PRO_NMOD) + F.gw; stride = PRO_NTR; lim = PRO_NTR; }
      tr_range(F, scr, it, stride, lim); }
    if (blockIdx.x == 0) {
        float* ROPE = (float*)(F.ws + WS_SM + SM_ROPE); float* LAM = (float*)(F.ws + WS_SM + SM_LAM);
        for (int i = F.tid; i < 1024; i += 512) { const int pos = i >> 4, fi = i & 15; const float inv = __builtin_amdgcn_exp2f(-(float)fi * (13.287712379549449f / 16.0f)); const float ang = (float)pos * inv;
            ROPE[2 * i] = __cosf(ang); ROPE[2 * i + 1] = __sinf(ang); }
        if (F.tid < 2) { const int l = F.tid; const float* lm = GIN(IN_LAM) + l * 256; float s1 = 0.f, s2 = 0.f;
            for (int i = 0; i < 64; ++i) { s1 += lm[i] * lm[64 + i]; s2 += lm[128 + i] * lm[192 + i]; }
            const float li = 0.8f - 0.6f * __expf(-0.3f * (float)l);
            LAM[2 * l] = __expf(s1) - __expf(s2) + li; LAM[2 * l + 1] = li; }
    }
}

__device__ __forceinline__ void norm_row(const Frame& F, const float* xr, const float* g, const float* mod, bf16* hrow, f32x4 (&h)[4]) {
    float ss = 0.f;
#pragma unroll
    for (int j = 0; j < 4; ++j) { h[j] = *(const f32x4*)(xr + 256 * j + 4 * F.lane); ss += (h[j].x * h[j].x + h[j].y * h[j].y) + (h[j].z * h[j].z + h[j].w * h[j].w); }
    const float rs = rsqrtf(wave_sum(ss) * (1.0f / DM) + RMS_EPS);
#pragma unroll
    for (int j = 0; j < 4; ++j) { const int c = 256 * j + 4 * F.lane; const f32x4 gg = *(const f32x4*)(g + c), sh = *(const f32x4*)(mod + c), sc = *(const f32x4*)(mod + 1024 + c);
        h[j] = (h[j] * rs) * gg * (sc + 1.0f) + sh;
        u32x2 o; o.x = pk2(h[j].x, h[j].y); o.y = pk2(h[j].z, h[j].w); *(u32x2*)(hrow + c) = o; }
}
__device__ __forceinline__ void phase_norm(const Frame& F, int l, int which, const float* xl, const float* xc) {
    const float* MOD = (const float*)(F.ws + WS_SM); bf16* HB = (bf16*)(F.ws + WS_HB);
    const float* g = F.ap->in[which ? IN_GN2 : IN_GN1] + l * DM;
    for (int row = F.gw; row < NROW; row += F.ngw) {
        const int b = row / RPB, rr = row - b * RPB; const bool isc = rr < CTX;
        const float* xr = isc ? xc + ((size_t)b * CTX + rr) * DM : xl + ((size_t)b * SEQ + rr - CTX) * DM;
        const float* mod = MOD + ((size_t)l * 9 + (isc ? 8 : b)) * 6144 + which * 3072;
        f32x4 h[4]; norm_row(F, xr, g, mod, HB + (size_t)row * DM, h);
    }
}
__device__ __forceinline__ float dot16(const u32x4 a, const u32x4 c, const f32x4 s0, const f32x4 s1, const f32x4 s2, const f32x4 s3) {
    float d = __uint_as_float(a.x << 16) * s0.x + __uint_as_float(a.x & 0xffff0000u) * s0.y + __uint_as_float(a.y << 16) * s0.z + __uint_as_float(a.y & 0xffff0000u) * s0.w;
    d += __uint_as_float(a.z << 16) * s1.x + __uint_as_float(a.z & 0xffff0000u) * s1.y + __uint_as_float(a.w << 16) * s1.z + __uint_as_float(a.w & 0xffff0000u) * s1.w;
    d += __uint_as_float(c.x << 16) * s2.x + __uint_as_float(c.x & 0xffff0000u) * s2.y + __uint_as_float(c.y << 16) * s2.z + __uint_as_float(c.y & 0xffff0000u) * s2.w;
    d += __uint_as_float(c.z << 16) * s3.x + __uint_as_float(c.z & 0xffff0000u) * s3.y + __uint_as_float(c.w << 16) * s3.z + __uint_as_float(c.w & 0xffff0000u) * s3.w;
    return d;
}
__device__ __forceinline__ void phase_shiftw(const Frame& F) {
    constexpr int NR = 2 * FFD + NZ, PER = 5;
    const float* MOD = (const float*)(F.ws + WS_SM); float* SWG = (float*)(F.ws + WS_SM + SM_SWGU); float* SWI = (float*)(F.ws + WS_SM + SM_SWIN);
    if (F.gw >= NR) return;
    u32x4 wa[PER], wc[PER];
#pragma unroll
    for (int i = 0; i < PER; ++i) { const int it_ = F.gw + i * F.ngw, it = it_ < NR ? it_ : F.gw; const bool gu = it < 2 * FFD;
        const bf16* wrow = (const bf16*)(F.ws + (gu ? W_GU : W_IN1)) + (size_t)(gu ? it : it - 2 * FFD) * DM + 16 * F.lane;
        wa[i] = *(const u32x4*)wrow; wc[i] = *(const u32x4*)(wrow + 8); }
#pragma unroll
    for (int r = 0; r < 9; ++r) { const float* sg = MOD + 3072 + (size_t)r * 6144 + 16 * F.lane; const float* si = MOD + (size_t)(9 + r) * 6144 + 16 * F.lane;
        const f32x4 g0 = *(const f32x4*)sg, g1 = *(const f32x4*)(sg + 4), g2 = *(const f32x4*)(sg + 8), g3 = *(const f32x4*)(sg + 12);
        const f32x4 i0 = *(const f32x4*)si, i1 = *(const f32x4*)(si + 4), i2 = *(const f32x4*)(si + 8), i3 = *(const f32x4*)(si + 12);
        float d[PER];
#pragma unroll
        for (int i = 0; i < PER; ++i) { const int it_ = F.gw + i * F.ngw, it = it_ < NR ? it_ : F.gw; const bool gu = it < 2 * FFD;
            d[i] = gu ? dot16(wa[i], wc[i], g0, g1, g2, g3) : dot16(wa[i], wc[i], i0, i1, i2, i3); }
#pragma unroll
        for (int o = 1; o < 64; o <<= 1)
#pragma unroll
            for (int i = 0; i < PER; ++i) d[i] += __shfl_xor(d[i], o);
        if (F.lane == 0) {
#pragma unroll
            for (int i = 0; i < PER; ++i) { const int it = F.gw + i * F.ngw; if (it < NR) { if (it < 2 * FFD) SWG[(size_t)r * (2 * FFD) + it] = d[i]; else SWI[(size_t)r * NZ + it - 2 * FFD] = d[i]; } } }
    }
}
__device__ __forceinline__ f32x4 ldx_bf(const float* xl, int tok, int c) { const u32x2 q = *(const u32x2*)((const bf16*)xl + (size_t)tok * (2 * DM) + c);
    return (f32x4){__uint_as_float(q.x << 16), __uint_as_float(q.x & 0xffff0000u), __uint_as_float(q.y << 16), __uint_as_float(q.y & 0xffff0000u)}; }
__device__ __forceinline__ void phase_norm_router(const Frame& F, const float* xl) {
    const int l = 1;
    const float* MOD = (const float*)(F.ws + WS_SM); bf16* HB = (bf16*)(F.ws + WS_HB);
    const float* g = GIN(IN_GN2) + l * DM; const float* wr = GIN(IN_WR);
    LAS int* lcnt = (LAS int*)(F.lds); LAS int* lbase = lcnt + 8; LAS int* ri = lcnt + 16;
    LAS float* rw = (LAS float*)(ri + 128 * 4);
    unsigned* gcnt = (unsigned*)(F.ws + WS_CTL) + CW_CNT;
    int* tok_of = (int*)(F.ws + WS_ML); u32x4* tokinfo = (u32x4*)(F.ws + WS_ML + ML_TOKINFO);
    f32x4 w0[4][4], w1[4][4];
#pragma unroll
    for (int j = 0; j < 4; ++j)
#pragma unroll
        for (int q = 0; q < 4; ++q) { const float* wp = wr + (size_t)(256 * j + 4 * F.lane + q) * 8; w0[j][q] = *(const f32x4*)wp; w1[j][q] = *(const f32x4*)(wp + 4); }
    f32x4 gg[4];
#pragma unroll
    for (int j = 0; j < 4; ++j) gg[j] = *(const f32x4*)(g + 256 * j + 4 * F.lane);
    for (int blk = blockIdx.x; blk < NLAT / 128; blk += F.G) {
        if (F.tid < 8) lcnt[F.tid] = 0;
        __syncthreads();
        const int tok0 = blk * 128 + F.wave * 16, b = tok0 / SEQ;
        const float* mod = MOD + ((size_t)l * 9 + b) * 6144 + 3072;
        f32x4 shv[4], scv[4];
#pragma unroll
        for (int j = 0; j < 4; ++j) { shv[j] = *(const f32x4*)(mod + 256 * j + 4 * F.lane); scv[j] = *(const f32x4*)(mod + 1024 + 256 * j + 4 * F.lane) + 1.0f; }
        f32x4 xn[4];
#pragma unroll
        for (int j = 0; j < 4; ++j) xn[j] = ldx_bf(xl, tok0, 256 * j + 4 * F.lane);
        for (int rr = 0; rr < 16; ++rr) {
            const int lrow = F.wave * 16 + rr, token = tok0 + rr, t = token - b * SEQ, row = b * RPB + CTX + t;
            f32x4 h[4];
#pragma unroll
            for (int j = 0; j < 4; ++j) h[j] = xn[j];
            if (rr + 1 < 16) {
#pragma unroll
                for (int j = 0; j < 4; ++j) xn[j] = ldx_bf(xl, token + 1, 256 * j + 4 * F.lane); }
            float ss = 0.f;
#pragma unroll
            for (int j = 0; j < 4; ++j) ss += (h[j].x * h[j].x + h[j].y * h[j].y) + (h[j].z * h[j].z + h[j].w * h[j].w);
            const float rs = rsqrtf(wave_sum(ss) * (1.0f / DM) + RMS_EPS);
            f32x4 la = {0.f, 0.f, 0.f, 0.f}, lb = {0.f, 0.f, 0.f, 0.f};
#pragma unroll
            for (int j = 0; j < 4; ++j) { h[j] = (h[j] * rs) * gg[j] * scv[j] + shv[j];
                u32x2 o; o.x = pk2(h[j].x, h[j].y); o.y = pk2(h[j].z, h[j].w); *(u32x2*)(HB + (size_t)row * DM + 256 * j + 4 * F.lane) = o;
                la += w0[j][0] * h[j].x + w0[j][1] * h[j].y + w0[j][2] * h[j].z + w0[j][3] * h[j].w;
                lb += w1[j][0] * h[j].x + w1[j][1] * h[j].y + w1[j][2] * h[j].z + w1[j][3] * h[j].w; }
            float lg[8] = {la.x, la.y, la.z, la.w, lb.x, lb.y, lb.z, lb.w};
#pragma unroll
            for (int e = 0; e < 8; ++e) lg[e] = wave_sum(lg[e]);
            int i1 = 0; float v1 = lg[0];
#pragma unroll
            for (int e = 1; e < 8; ++e) if (lg[e] > v1) { v1 = lg[e]; i1 = e; }
            int i2 = -1; float v2 = -3.0e38f;
#pragma unroll
            for (int e = 0; e < 8; ++e) if (e != i1 && lg[e] > v2) { v2 = lg[e]; i2 = e; }
            if (F.lane == 0) { const float wgt1 = 1.0f / (1.0f + __expf(v2 - v1));
                const int p1 = __hip_atomic_fetch_add(lcnt + i1, 1, __ATOMIC_RELAXED, __HIP_MEMORY_SCOPE_WORKGROUP), p2 = __hip_atomic_fetch_add(lcnt + i2, 1, __ATOMIC_RELAXED, __HIP_MEMORY_SCOPE_WORKGROUP);
                ri[lrow * 4 + 0] = i1; ri[lrow * 4 + 1] = i2; ri[lrow * 4 + 2] = p1; ri[lrow * 4 + 3] = p2; rw[lrow * 2] = wgt1; rw[lrow * 2 + 1] = 1.0f - wgt1; }
        }
        __syncthreads();
        if (F.tid < 8) lbase[F.tid] = (int)__hip_atomic_fetch_add(gcnt + 64 * F.tid, (unsigned)lcnt[F.tid], __ATOMIC_RELAXED, __HIP_MEMORY_SCOPE_AGENT);
        __syncthreads();
        if (F.tid < 128) { const int token = blk * 128 + F.tid; const int e1 = ri[F.tid * 4], e2 = ri[F.tid * 4 + 1]; const int p1 = lbase[e1] + ri[F.tid * 4 + 2], p2 = lbase[e2] + ri[F.tid * 4 + 3];
            tok_of[e1 * NLAT + p1] = token; tok_of[e2 * NLAT + p2] = token;
            u32x4 ti; ti.x = ((unsigned)e1 << 20) | (unsigned)p1; ti.y = ((unsigned)e2 << 20) | (unsigned)p2; ti.z = __float_as_uint(rw[F.tid * 2]); ti.w = __float_as_uint(rw[F.tid * 2 + 1]); tokinfo[token] = ti; }
        __syncthreads();
    }
}
__device__ __forceinline__ int moe_tiles(const Frame& F, int (&tb)[8], int (&cnt)[8]) {
    const unsigned* gcnt = (const unsigned*)(F.ws + WS_CTL) + CW_CNT; int t = 0;
#pragma unroll
    for (int e = 0; e < 8; ++e) { cnt[e] = (int)__builtin_amdgcn_readfirstlane((int)__hip_atomic_load(gcnt + 64 * e, __ATOMIC_RELAXED, __HIP_MEMORY_SCOPE_AGENT)); tb[e] = t; t += (cnt[e] + 255) >> 8; }
    return t;
}
__device__ __forceinline__ void phase_moe_prep(const Frame& F) {
    int tb[8], cnt[8]; const int T = moe_tiles(F, tb, cnt);
    const int* tok_of = (const int*)(F.ws + WS_ML); int* rowlist = (int*)(F.ws + WS_ML + ML_ROWLIST);
    for (int slot = blockIdx.x * 512 + F.tid; slot < T * 256; slot += F.G * 512) {
        const int tile = slot >> 8; int e = 0;
#pragma unroll
        for (int k = 1; k < 8; ++k) e += (tile >= tb[k]) ? 1 : 0;
        int tbe = 0, ce = 0;
#pragma unroll
        for (int k = 0; k < 8; ++k) { tbe = (k == e) ? tb[k] : tbe; ce = (k == e) ? cnt[k] : ce; }
        const int pos = slot - tbe * 256; int row = CTX;
        if (pos < ce) { const int token = tok_of[e * NLAT + pos]; const int b = token / SEQ; row = b * RPB + CTX + (token - b * SEQ); }
        rowlist[slot] = row;
    }
}
constexpr int MOE_PER_E = 3 * 16 * (FFE / 32), MOE_ITEMS = NEXP * MOE_PER_E;
__device__ __forceinline__ TrItem moe_desc(const Frame& F, int it) { const int e = it / MOE_PER_E, r = it % MOE_PER_E;
    return ffn_tr_desc(GIN(IN_MG) + (size_t)e * DM * FFE, GIN(IN_MU) + (size_t)e * DM * FFE, GIN(IN_MD) + (size_t)e * FFE * DM, FFE,
                       (bf16*)(F.ws + WS_MW + e * MW_STRIDE), (bf16*)(F.ws + WS_MW + e * MW_STRIDE + MW_DN), r); }
__device__ __forceinline__ void moe_convert_items(const Frame& F, int it_lo, int it_hi, int rank, int nrank) {
    LAS float* scr = (LAS float*)(F.lds + 40960 + F.wave * 8704);
    const int step = nrank * 8; int it = it_lo + rank * 8 + F.wave;
    if (it >= it_hi) return;
    float ta[32], tb2[32]; TrItem da = moe_desc(F, it), db = da;
    tr_load(da, ta, F.lane);
    for (;;) {
        const bool nb_ = it + step < it_hi; if (nb_) { db = moe_desc(F, it + step); tr_load(db, tb2, F.lane); }
        tr_finish(da, ta, scr, F.lane); it += step; if (!nb_) break;
        const bool na_ = it + step < it_hi; if (na_) { da = moe_desc(F, it + step); tr_load(da, ta, F.lane); }
        tr_finish(db, tb2, scr, F.lane); it += step; if (!na_) break;
    }
}
constexpr size_t YX_SLAB = (size_t)8 * 256 * DM;
constexpr int YX_KS = 7;
constexpr size_t WS_YX = WS_W;
static_assert(FFE % (YX_KS * 128) == 0 && YX_KS * YX_SLAB * 2 <= WS_ZB - WS_W, "overflow slabs");
__device__ __forceinline__ f32x4 unpk4(const u32x2 q) { return (f32x4){__uint_as_float(q.x << 16), __uint_as_float(q.x & 0xffff0000u), __uint_as_float(q.y << 16), __uint_as_float(q.y & 0xffff0000u)}; }
__device__ __forceinline__ void phase_final(const Frame& F) {
    int tb[8], cnt[8]; (void)moe_tiles(F, tb, cnt);
    const float* MOD = (const float*)(F.ws + WS_SM); const u32x4* tokinfo = (const u32x4*)(F.ws + WS_ML + ML_TOKINFO);
    const bf16* YB0 = (const bf16*)(F.ws + WS_YB0); const bf16* YB1 = (const bf16*)(F.ws + WS_HB); const float* gf = GIN(IN_GF);
    f32x4 gfv[4];
#pragma unroll
    for (int j = 0; j < 4; ++j) gfv[j] = *(const f32x4*)(gf + 256 * j + 4 * F.lane);
    for (int t0 = F.gw; t0 < NLAT; t0 += 4 * F.ngw) {
        u32x4 ti[4];
#pragma unroll
        for (int i = 0; i < 4; ++i) { const int token = t0 + i * F.ngw; ti[i] = tokinfo[token < NLAT ? token : t0]; }
        f32x4 x[4][4]; u32x2 ya[4][4], yb[4][4]; bool ov1[4], ov2[4]; const bf16* yp1[4]; const bf16* yp2[4];
#pragma unroll
        for (int i = 0; i < 4; ++i) { const int tk = t0 + i * F.ngw, token = tk < NLAT ? tk : t0;
            const int e1 = ti[i].x >> 20, e2 = ti[i].y >> 20; int t1 = 0, t2 = 0;
#pragma unroll
            for (int k = 0; k < 8; ++k) { t1 = (k == e1) ? tb[k] : t1; t2 = (k == e2) ? tb[k] : t2; }
            const int s1 = t1 * 256 + (int)(ti[i].x & 0xFFFFFu), s2 = t2 * 256 + (int)(ti[i].y & 0xFFFFFu);
            const bf16* YX = (const bf16*)(F.ws + WS_YX); const bool o1 = s1 >= 65536, o2 = s2 >= 65536;
            const bf16* y1 = o1 ? YX + (size_t)(s1 - 65536) * DM : s1 < PASS0_TILES * 256 ? YB0 + (size_t)s1 * DM : YB1 + (size_t)(s1 - PASS0_TILES * 256) * DM;
            const bf16* y2 = o2 ? YX + (size_t)(s2 - 65536) * DM : s2 < PASS0_TILES * 256 ? YB0 + (size_t)s2 * DM : YB1 + (size_t)(s2 - PASS0_TILES * 256) * DM;
            ov1[i] = o1; ov2[i] = o2; yp1[i] = y1; yp2[i] = y2;
#pragma unroll
            for (int j = 0; j < 4; ++j) { const int c = 256 * j + 4 * F.lane; x[i][j] = ldx_bf((const float*)F.out, token, c); ya[i][j] = *(const u32x2*)(y1 + c); yb[i][j] = *(const u32x2*)(y2 + c); } }
#pragma unroll
        for (int i = 0; i < 4; ++i) { const int token = t0 + i * F.ngw; if (token < NLAT) {
            const int b = token / SEQ; const float w1 = __uint_as_float(ti[i].z), w2 = __uint_as_float(ti[i].w);
            const float* ga = MOD + ((size_t)9 + b) * 6144 + 5120; float* xr = (float*)F.out + (size_t)token * DM; float ss = 0.f;
            f32x4 a1[4], a2[4];
#pragma unroll
            for (int j = 0; j < 4; ++j) { a1[j] = unpk4(ya[i][j]); a2[j] = unpk4(yb[i][j]); }
            if (ov1[i]) {
                for (int ks = 1; ks < YX_KS; ++ks) {
#pragma unroll
                    for (int j = 0; j < 4; ++j) a1[j] += unpk4(*(const u32x2*)(yp1[i] + (size_t)ks * YX_SLAB + 256 * j + 4 * F.lane)); } }
            if (ov2[i]) {
                for (int ks = 1; ks < YX_KS; ++ks) {
#pragma unroll
                    for (int j = 0; j < 4; ++j) a2[j] += unpk4(*(const u32x2*)(yp2[i] + (size_t)ks * YX_SLAB + 256 * j + 4 * F.lane)); } }
#pragma unroll
            for (int j = 0; j < 4; ++j) { const int c = 256 * j + 4 * F.lane; const f32x4 y = a1[j] * w1 + a2[j] * w2;
                x[i][j] = x[i][j] + *(const f32x4*)(ga + c) * y; ss += (x[i][j].x * x[i][j].x + x[i][j].y * x[i][j].y) + (x[i][j].z * x[i][j].z + x[i][j].w * x[i][j].w); }
            const float rs = rsqrtf(wave_sum(ss) * (1.0f / DM) + RMS_EPS);
#pragma unroll
            for (int j = 0; j < 4; ++j) { const int c = 256 * j + 4 * F.lane; *(f32x4*)(xr + c) = (x[i][j] * rs) * gfv[j]; } } }
    }
}
__device__ __forceinline__ float log_sigmoid_f(float x) { return fminf(x, 0.f) - __logf(1.0f + __expf(-fabsf(x))); }
__device__ __forceinline__ size_t gla_idx(int b, int dir, int h, int n) { return (size_t)((b * 2 + dir) * 4 + h) * NCH + n; }

template <int BST>
__device__ __forceinline__ float gla_cumsum(const bf16* Z, int base, int h, int dir, const float* bdec, LAS float* bc, int lane) {
    const int k = lane & 31, half = lane >> 5; const float bd = bdec[dir * 128 + h * 32 + k];
    const bf16* zp = Z + (size_t)(base + half * 32) * NZ + ZLG + dir * 128 + h * 32 + k;
    float lg[32];
#pragma unroll
    for (int s = 0; s < 32; ++s) lg[s] = log_sigmoid_f(bf2f(zp[(size_t)s * NZ]) + bd) * (1.0f / 16.0f);
    float tot = 0.f;
#pragma unroll
    for (int s = 0; s < 32; ++s) tot += lg[s];
    const float other = __shfl_xor(tot, 32);
    if (dir == 0) { float run = half ? other : 0.f;
#pragma unroll
        for (int s = 0; s < 32; ++s) { run += lg[s]; bc[(half * 32 + s) * BST + k] = run; } }
    else { float run = half ? 0.f : other;
#pragma unroll
        for (int s = 31; s >= 0; --s) { run += lg[s]; bc[(half * 32 + s) * BST + k] = run; } }
    return tot + other;
}

typedef float f32x16_t __attribute__((ext_vector_type(16)));
__device__ __forceinline__ void phase_gla_a(const Frame& F, int l) {
    const bf16* Z = (const bf16*)(F.ws + WS_ZB); float* U = (float*)(F.ws + WS_U); float* BE = (float*)(F.ws + WS_BE);
    const float* bdec = GIN(IN_BDEC) + l * 256;
    const int h = F.wave & 3, dir = F.wave >> 2, k = F.lane & 31, half = F.lane >> 5;
    const float bd = bdec[dir * 128 + h * 32 + k];
    for (int it = blockIdx.x; it < NB * NCH; it += F.G) {
        const int b = it / NCH, n = it - b * NCH, base = b * RPB + n * 64;
        const bf16* zp = Z + (size_t)(base + half * 32) * NZ + ZLG + dir * 128 + h * 32 + k;
        const bf16* kp = Z + (size_t)(base + half * 32) * NZ + ZGK + h * 32 + k;
        const bf16* vp = Z + (size_t)(base + half * 32) * NZ + ZGV + h * 64 + k;
        bf16 lgv[32], kv[32], va[32], vb[32];
#pragma unroll
        for (int s = 0; s < 32; ++s) { lgv[s] = zp[(size_t)s * NZ]; kv[s] = kp[(size_t)s * NZ]; va[s] = vp[(size_t)s * NZ]; vb[s] = vp[(size_t)s * NZ + 32]; }
        __builtin_amdgcn_sched_barrier(0);
        float lg[32];
#pragma unroll
        for (int s = 0; s < 32; ++s) lg[s] = log_sigmoid_f(bf2f(lgv[s]) + bd) * (1.0f / 16.0f);
        float tot = 0.f;
#pragma unroll
        for (int s = 0; s < 32; ++s) tot += lg[s];
        const float other = __shfl_xor(tot, 32); const float bend = tot + other;
        if (dir == 0) { float run = half ? other : 0.f;
#pragma unroll
            for (int s = 0; s < 32; ++s) { run += lg[s]; lg[s] = run; } }
        else { float run = half ? 0.f : other;
#pragma unroll
            for (int s = 31; s >= 0; --s) { run += lg[s]; lg[s] = run; } }
        const size_t gi = gla_idx(b, dir, h, n);
        if (F.lane < 32) BE[gi * 32 + F.lane] = bend;
#pragma unroll
        for (int s = 0; s < 32; ++s) lg[s] = bf2f(kv[s]) * __expf(bend - lg[s]);
        f32x16_t acc0, acc1;
#pragma unroll
        for (int r = 0; r < 16; ++r) { acc0[r] = 0.f; acc1[r] = 0.f; }
#pragma unroll
        for (int t = 0; t < 4; ++t) {
            u32x4 aw, b0, b1;
            aw.x = pg8::cvt_pk_bf16(lg[8 * t], lg[8 * t + 1]); aw.y = pg8::cvt_pk_bf16(lg[8 * t + 2], lg[8 * t + 3]); aw.z = pg8::cvt_pk_bf16(lg[8 * t + 4], lg[8 * t + 5]); aw.w = pg8::cvt_pk_bf16(lg[8 * t + 6], lg[8 * t + 7]);
            b0.x = (unsigned)va[8 * t] | ((unsigned)va[8 * t + 1] << 16); b0.y = (unsigned)va[8 * t + 2] | ((unsigned)va[8 * t + 3] << 16); b0.z = (unsigned)va[8 * t + 4] | ((unsigned)va[8 * t + 5] << 16); b0.w = (unsigned)va[8 * t + 6] | ((unsigned)va[8 * t + 7] << 16);
            b1.x = (unsigned)vb[8 * t] | ((unsigned)vb[8 * t + 1] << 16); b1.y = (unsigned)vb[8 * t + 2] | ((unsigned)vb[8 * t + 3] << 16); b1.z = (unsigned)vb[8 * t + 4] | ((unsigned)vb[8 * t + 5] << 16); b1.w = (unsigned)vb[8 * t + 6] | ((unsigned)vb[8 * t + 7] << 16);
            acc0 = __builtin_amdgcn_mfma_f32_32x32x16_bf16(__builtin_bit_cast(bf16x8, aw), __builtin_bit_cast(bf16x8, b0), acc0, 0, 0, 0);
            acc1 = __builtin_amdgcn_mfma_f32_32x32x16_bf16(__builtin_bit_cast(bf16x8, aw), __builtin_bit_cast(bf16x8, b1), acc1, 0, 0, 0); }
        float* up = U + gi * 2048 + k;
#pragma unroll
        for (int r = 0; r < 16; ++r) { const int kk = (r & 3) + 8 * (r >> 2) + 4 * half; up[kk * 64] = acc0[r]; up[kk * 64 + 32] = acc1[r]; }
    }
}
__device__ __forceinline__ void phase_gla_scan(const Frame& F) {
    const float* U = (const float*)(F.ws + WS_U); const float* BE = (const float*)(F.ws + WS_BE); float* SP = (float*)(F.ws + WS_SP);
    for (int it = blockIdx.x; it < 256; it += F.G) {
        const int chain = it >> 2, vs = it & 3, b = chain >> 3, dir = (chain >> 2) & 1, h = chain & 3;
        const int k = F.tid >> 4, v = vs * 16 + (F.tid & 15);
        float st = 0.f;
        for (int blk = 0; blk < 4; ++blk) {
            float uu[17], dd[17];
#pragma unroll
            for (int j = 0; j < 17; ++j) { const int i = blk * 17 + j; const int n = dir == 0 ? i : (i < 4 ? 3 - i : 71 - i); const size_t gi = gla_idx(b, dir, h, n);
                uu[j] = U[gi * 2048 + k * 64 + v]; dd[j] = BE[gi * 32 + k]; }
#pragma unroll
            for (int j = 0; j < 17; ++j) { const int i = blk * 17 + j; const int n = dir == 0 ? i : (i < 4 ? 3 - i : 71 - i); const size_t gi = gla_idx(b, dir, h, n);
                SP[gi * 2048 + k * 64 + v] = st; st = __expf(dd[j]) * st + uu[j]; }
        }
    }
}
namespace dat {
using f32x16 = __attribute__((ext_vector_type(16))) float;
using s16x4 = __attribute__((ext_vector_type(4))) short;
constexpr int SHM_V = 64 * 128 * 2, SHM_K = 64 * 128 * 2;
constexpr float THR = 11.5f;
#define KSWZ(row, colB) ((row) * 256 + ((colB) ^ (((row) & 7) << 4)))
#define SBAR() __builtin_amdgcn_sched_barrier(0)
__device__ __forceinline__ int crow(int r, int hi) { return (r & 3) + 8 * (r >> 2) + 4 * hi; }
__device__ __forceinline__ unsigned cvtpk(float lo, float hi) { unsigned r; asm volatile("v_cvt_pk_bf16_f32 %0, %1, %2" : "=v"(r) : "v"(lo), "v"(hi)); return r; }
__device__ __forceinline__ void partialSM(f32x16& p0, f32x16& p1, float& m_reg, float& mn, float& alpha) {
  float pmax = p0[0];
#pragma unroll
  for (int r = 1; r < 16; ++r) pmax = fmaxf(pmax, p0[r]);
#pragma unroll
  for (int r = 0; r < 16; ++r) pmax = fmaxf(pmax, p1[r]);
  { auto rr = __builtin_amdgcn_permlane32_swap(__float_as_uint(pmax), __float_as_uint(pmax), false, false);
    pmax = fmaxf(__uint_as_float(rr[0]), __uint_as_float(rr[1])); }
  if (__builtin_expect(__all(pmax - m_reg <= THR), 1)) { mn = m_reg; alpha = 1.f; }
  else { mn = fmaxf(m_reg, pmax); alpha = __builtin_amdgcn_exp2f(m_reg - mn); m_reg = mn; }
#pragma unroll
  for (int r = 0; r < 16; ++r) p0[r] = p0[r] - mn;
#pragma unroll
  for (int r = 0; r < 16; ++r) p1[r] = p1[r] - mn;
#pragma unroll
  for (int r = 0; r < 16; ++r) p0[r] = __builtin_amdgcn_exp2f(p0[r]);
}
__device__ __forceinline__ float psm_max(const f32x16& p0, const f32x16& p1) {
  float pmax = p0[0];
#pragma unroll
  for (int r = 1; r < 16; ++r) pmax = fmaxf(pmax, p0[r]);
#pragma unroll
  for (int r = 0; r < 16; ++r) pmax = fmaxf(pmax, p1[r]);
  auto rr = __builtin_amdgcn_permlane32_swap(__float_as_uint(pmax), __float_as_uint(pmax), false, false);
  return fmaxf(__uint_as_float(rr[0]), __uint_as_float(rr[1]));
}
__device__ __forceinline__ void psm_decide(float pmax, float& m_reg, float& mn, float& alpha) {
  if (__builtin_expect(__all(pmax - m_reg <= THR), 1)) { mn = m_reg; alpha = 1.f; }
  else { mn = fmaxf(m_reg, pmax); alpha = __builtin_amdgcn_exp2f(m_reg - mn); m_reg = mn; }
}
__device__ __forceinline__ void psm_sub(f32x16& p0, f32x16& p1, float mn) {
#pragma unroll
  for (int r = 0; r < 16; ++r) { p0[r] = p0[r] - mn; p1[r] = p1[r] - mn; }
}
__device__ __forceinline__ void psm_exp0(f32x16& p0) {
#pragma unroll
  for (int r = 0; r < 16; ++r) p0[r] = __builtin_amdgcn_exp2f(p0[r]);
}
__device__ __forceinline__ void qkt_r(f32x16& p0, f32x16& p1, const LAS char* Ks, const bf16x8* qr, const f32x16& negm, int r32, int hi, int map) {
#pragma unroll
  for (int d0 = 0; d0 < 4; ++d0) { const int cb = ((map * 4 + d0) * 16 + hi * 8) * 2;
    const bf16x8 b0 = *(const LAS bf16x8*)(Ks + KSWZ(r32, cb));
    const bf16x8 b1 = *(const LAS bf16x8*)(Ks + KSWZ(32 + r32, cb));
    if (d0 == 0) { p0 = __builtin_amdgcn_mfma_f32_32x32x16_bf16(b0, qr[0], negm, 0, 0, 0); p1 = __builtin_amdgcn_mfma_f32_32x32x16_bf16(b1, qr[0], negm, 0, 0, 0); }
    else { p0 = __builtin_amdgcn_mfma_f32_32x32x16_bf16(b0, qr[d0], p0, 0, 0, 0); p1 = __builtin_amdgcn_mfma_f32_32x32x16_bf16(b1, qr[d0], p1, 0, 0, 0); } }
}
__device__ __forceinline__ void psm_decide_r(float pmax, float& m_reg, f32x16& negm, float& dl, float& alpha, bool force) {
  if (__builtin_expect(!force && __all(pmax <= THR), 1)) { dl = 0.f; alpha = 1.f; }
  else { dl = force ? pmax : fmaxf(pmax, 0.f); alpha = __builtin_amdgcn_exp2f(-dl); m_reg += dl;
#pragma unroll
    for (int r = 0; r < 16; ++r) negm[r] = -m_reg; }
}
__device__ __forceinline__ void psm_sub_r(f32x16& p0, f32x16& p1, float dl) {
  if (dl != 0.f) {
#pragma unroll
    for (int r = 0; r < 16; ++r) { p0[r] -= dl; p1[r] -= dl; } }
}
__device__ __forceinline__ void finishSM(f32x16& p0, f32x16& p1, float alpha, float& l_reg, bf16x8& pa0, bf16x8& pa1, bf16x8& pa2, bf16x8& pa3) {
#pragma unroll
  for (int r = 0; r < 16; ++r) p1[r] = __builtin_amdgcn_exp2f(p1[r]);
  float ps = 0;
#pragma unroll
  for (int r = 0; r < 16; ++r) ps += p0[r];
#pragma unroll
  for (int r = 0; r < 16; ++r) ps += p1[r];
  { auto rr = __builtin_amdgcn_permlane32_swap(__float_as_uint(ps), __float_as_uint(ps), false, false);
    ps = __uint_as_float(rr[0]) + __uint_as_float(rr[1]); }
  l_reg = l_reg * alpha + ps;
#define PK4(P, BASE, OUT) do { unsigned a0 = cvtpk(P[BASE + 0], P[BASE + 1]), a1 = cvtpk(P[BASE + 2], P[BASE + 3]);   \
    unsigned b0 = cvtpk(P[BASE + 4], P[BASE + 5]), b1 = cvtpk(P[BASE + 6], P[BASE + 7]);                              \
    auto r0 = __builtin_amdgcn_permlane32_swap(a0, b0, false, false); auto r1 = __builtin_amdgcn_permlane32_swap(a1, b1, false, false); \
    u32x4 w = {r0[0], r1[0], r0[1], r1[1]}; OUT = __builtin_bit_cast(bf16x8, w); } while (0)
  PK4(p0, 0, pa0); PK4(p0, 8, pa1); PK4(p1, 0, pa2); PK4(p1, 8, pa3);
#undef PK4
}
__device__ __forceinline__ void qkt(f32x16& p0, f32x16& p1, const LAS char* Ks, const bf16x8* qr, int r32, int hi, int map) {
  p0 = f32x16{}; p1 = f32x16{};
#pragma unroll
  for (int d0 = 0; d0 < 4; ++d0) { const int cb = ((map * 4 + d0) * 16 + hi * 8) * 2;
    const bf16x8 b0 = *(const LAS bf16x8*)(Ks + KSWZ(r32, cb));
    const bf16x8 b1 = *(const LAS bf16x8*)(Ks + KSWZ(32 + r32, cb));
    p0 = __builtin_amdgcn_mfma_f32_32x32x16_bf16(b0, qr[d0], p0, 0, 0, 0);
    p1 = __builtin_amdgcn_mfma_f32_32x32x16_bf16(b1, qr[d0], p1, 0, 0, 0); }
}
__device__ __forceinline__ int v_st(int k, int c) { const int kk = (k & ~0xC) | ((k & 4) << 1) | ((k & 8) >> 1); return ((kk >> 3) * 4 + (c >> 5)) * 512 + ((kk & 7) * 32 + (c & 31)) * 2; }
__device__ __forceinline__ int v_rd_base(int lane) { return ((lane & 3) << 3) | (((lane >> 2) & 3) << 6) | (((lane >> 4) & 1) << 5) | (((lane >> 5) & 1) << 8); }
constexpr int v_rd_off(int d0, int ks, int half) { return d0 * 512 + ks * 4096 + half * 2048; }
template <int OFF> __device__ __forceinline__ s16x4 tr_read(int vb) {
  s16x4 r; asm volatile("ds_read_b64_tr_b16 %0, %1 offset:%2" : "=&v"(r) : "v"(vb), "i"(OFF) : "memory"); return r;
}
template <int D0> __device__ __forceinline__ void pv_one(f32x16& od, int vb, bf16x8 pa0, bf16x8 pa1, bf16x8 pa2, bf16x8 pa3) {
  const s16x4 l0 = tr_read<v_rd_off(D0, 0, 0)>(vb), h0 = tr_read<v_rd_off(D0, 0, 1)>(vb), l1 = tr_read<v_rd_off(D0, 1, 0)>(vb), h1 = tr_read<v_rd_off(D0, 1, 1)>(vb);
  const s16x4 l2 = tr_read<v_rd_off(D0, 2, 0)>(vb), h2 = tr_read<v_rd_off(D0, 2, 1)>(vb), l3 = tr_read<v_rd_off(D0, 3, 0)>(vb), h3 = tr_read<v_rd_off(D0, 3, 1)>(vb);
  asm volatile("s_waitcnt lgkmcnt(0)" ::: "memory"); SBAR();
#define PK(L, H) (bf16x8){L[0], L[1], L[2], L[3], H[0], H[1], H[2], H[3]}
  od = __builtin_amdgcn_mfma_f32_32x32x16_bf16(pa0, PK(l0, h0), od, 0, 0, 0);
  od = __builtin_amdgcn_mfma_f32_32x32x16_bf16(pa1, PK(l1, h1), od, 0, 0, 0);
  od = __builtin_amdgcn_mfma_f32_32x32x16_bf16(pa2, PK(l2, h2), od, 0, 0, 0);
  od = __builtin_amdgcn_mfma_f32_32x32x16_bf16(pa3, PK(l3, h3), od, 0, 0, 0);
#undef PK
}
__device__ __forceinline__ void pv_d0(f32x16* o, int vb, bf16x8 pa0, bf16x8 pa1, bf16x8 pa2, bf16x8 pa3) {
  pv_one<0>(o[0], vb, pa0, pa1, pa2, pa3); pv_one<1>(o[1], vb, pa0, pa1, pa2, pa3); pv_one<2>(o[2], vb, pa0, pa1, pa2, pa3); pv_one<3>(o[3], vb, pa0, pa1, pa2, pa3);
}
template <bool CTXQ> __device__ __forceinline__ void diff_unit_fast(const Frame& F, int l, int b, int h, int qb) {
  const bf16* Z = (const bf16*)(F.ws + WS_ZB); bf16* CB = (bf16*)(F.ws + WS_CB);
  const int tid = F.tid, wid = F.wave, lane = F.lane, r32 = lane & 31, hi = lane >> 5, map = wid >> 2, qs = wid & 3;
  LAS char* lds = (LAS char*)F.lds;
  LAS char* V_lds = lds; LAS char* K_lds = lds + 3 * SHM_V;
  LAS float* wsf = (LAS float*)(lds + 3 * SHM_V + 3 * SHM_K) + wid * 64; LAS float* li_l = wsf; LAS float* al_l = wsf + 32;
  const int brow0 = b * RPB, qrow0 = brow0 + (CTXQ ? 0 : CTX) + qb * 128 + qs * 32;
  float m_reg = -1e30f, l_reg = 0; f32x16 o[4] = {}; bf16x8 qr[4];
  const bf16* Qw = Z + (size_t)(qrow0 + r32) * NZ + ZDQ + h * 128 + map * 64 + hi * 8;
#pragma unroll
  for (int d0 = 0; d0 < 4; ++d0) qr[d0] = *(const bf16x8*)(Qw + d0 * 16);
  const bf16* Kh = Z + (size_t)brow0 * NZ + ZDK + h * 128; const bf16* Vh = Z + (size_t)brow0 * NZ + ZDV + h * 128;
  const int sr = tid >> 4, sc = (tid & 15) * 8, vst0 = v_st(sr, sc), vst1 = v_st(32 + sr, sc);
  const int vb0 = (int)(unsigned)(uintptr_t)V_lds + v_rd_base(lane);
  bf16x8 sv0[2], sv1[2], sk0[2], sk1[2];
#define SLOAD(i, k0) do { sv0[i] = *(const bf16x8*)&Vh[(size_t)((k0) + sr) * NZ + sc]; sv1[i] = *(const bf16x8*)&Vh[(size_t)((k0) + 32 + sr) * NZ + sc]; \
    sk0[i] = *(const bf16x8*)&Kh[(size_t)((k0) + sr) * NZ + sc]; sk1[i] = *(const bf16x8*)&Kh[(size_t)((k0) + 32 + sr) * NZ + sc]; } while (0)
#define SWRITE(bb, i) do { *(LAS bf16x8*)(V_lds + (bb) * SHM_V + vst0) = sv0[i]; *(LAS bf16x8*)(V_lds + (bb) * SHM_V + vst1) = sv1[i]; const int kc = sc * 2; \
    *(LAS bf16x8*)(K_lds + (bb) * SHM_K + KSWZ(sr, kc)) = sk0[i]; *(LAS bf16x8*)(K_lds + (bb) * SHM_K + KSWZ(32 + sr, kc)) = sk1[i]; } while (0)
#define SWAIT() asm volatile("s_waitcnt vmcnt(4)" ::: "memory")
#define SYNC() __syncthreads()
#define PSM partialSM
#define FSM finishSM
#define PVD pv_d0
#define PV_PSM(vb_, P0, P1, MN, AL) do { float pm_; pv_one<0>(o[0], vb_, pa0, pa1, pa2, pa3); pm_ = psm_max(P0, P1); \
    pv_one<1>(o[1], vb_, pa0, pa1, pa2, pa3); psm_decide(pm_, m_reg, MN, AL); \
    pv_one<2>(o[2], vb_, pa0, pa1, pa2, pa3); psm_sub(P0, P1, MN); \
    pv_one<3>(o[3], vb_, pa0, pa1, pa2, pa3); psm_exp0(P0); } while (0)
#define RESC(a) do { if (__any((a) < 1.f)) { if (hi == 0) al_l[r32] = (a); asm volatile("s_waitcnt lgkmcnt(0)" ::: "memory"); \
    _Pragma("unroll") for (int d = 0; d < 4; ++d) _Pragma("unroll") for (int r = 0; r < 16; ++r) o[d][r] *= al_l[crow(r, hi)]; } } while (0)
  f32x16 pA0, pA1, pB0, pB1; float mnA, mnB, alA, alB; bf16x8 pa0, pa1, pa2, pa3; constexpr int NT = CTXQ ? 4 : NCH;
  SYNC();
  SLOAD(0, 0); asm volatile("s_waitcnt vmcnt(0)" ::: "memory"); SWRITE(0, 0); SYNC();
  qkt(pA0, pA1, K_lds, qr, r32, hi, map); PSM(pA0, pA1, m_reg, mnA, alA);
  SLOAD(1, 64); SLOAD(0, 128);
  SWAIT(); SWRITE(1, 1); SYNC();
  int bj = 1, bn = 2, bp = 0;
#define ROT3() do { const int t_ = bp; bp = bj; bj = bn; bn = t_; } while (0)
  for (int j = 1; j + 1 < NT; j += 2) {
    SBAR(); qkt(pB0, pB1, K_lds + bj * SHM_K, qr, r32, hi, map);
    FSM(pA0, pA1, alA, l_reg, pa0, pa1, pa2, pa3); SBAR();
    SLOAD(1, (j + 2) * 64); SBAR();
    PV_PSM(vb0 + bp * SHM_V, pB0, pB1, mnB, alB);
    SWAIT(); SWRITE(bn, 0);
    RESC(alB); SYNC(); ROT3();
    SBAR(); qkt(pA0, pA1, K_lds + bj * SHM_K, qr, r32, hi, map);
    FSM(pB0, pB1, alB, l_reg, pa0, pa1, pa2, pa3); SBAR();
    if (j + 3 < NT) SLOAD(0, (j + 3) * 64); SBAR();
    PV_PSM(vb0 + bp * SHM_V, pA0, pA1, mnA, alA);
    SWAIT(); if (j + 2 < NT) SWRITE(bn, 1);
    RESC(alA); SYNC(); ROT3();
  }
  SBAR(); qkt(pB0, pB1, K_lds + bj * SHM_K, qr, r32, hi, map);
  FSM(pA0, pA1, alA, l_reg, pa0, pa1, pa2, pa3); SBAR();
  PV_PSM(vb0 + bp * SHM_V, pB0, pB1, mnB, alB);
  RESC(alB);
  FSM(pB0, pB1, alB, l_reg, pa0, pa1, pa2, pa3); SBAR();
  PVD(o, vb0 + bj * SHM_V, pa0, pa1, pa2, pa3);
#undef ROT3
  if (hi == 0) li_l[r32] = l_reg; asm volatile("s_waitcnt lgkmcnt(0)" ::: "memory");
  float rli[16];
#pragma unroll
  for (int r = 0; r < 16; ++r) rli[r] = __builtin_amdgcn_rcpf(li_l[crow(r, hi)]);
  __syncthreads();
  LAS float* X = (LAS float*)lds + qs * 4096 + lane;
  if (map == 1) {
#pragma unroll
    for (int d0 = 0; d0 < 4; ++d0)
#pragma unroll
      for (int r = 0; r < 16; ++r) X[(d0 * 16 + r) * 64] = o[d0][r] * rli[r];
  }
  __syncthreads();
  if (map == 0) {
    const float* LAM = (const float*)(F.ws + WS_SM + SM_LAM); const float lam = LAM[2 * l], li = LAM[2 * l + 1];
    const float* gd = GIN(IN_GDIFF) + l * 128;
    float g4[4];
#pragma unroll
    for (int d0 = 0; d0 < 4; ++d0) g4[d0] = gd[d0 * 32 + r32] * (1.0f - li);
#pragma unroll
    for (int r = 0; r < 16; ++r) { float ss = 0.f;
#pragma unroll
      for (int d0 = 0; d0 < 4; ++d0) { const float v = o[d0][r] * rli[r] - lam * X[(d0 * 16 + r) * 64]; o[d0][r] = v; ss += v * v; }
      ss += __shfl_xor(ss, 1); ss += __shfl_xor(ss, 2); ss += __shfl_xor(ss, 4); ss += __shfl_xor(ss, 8); ss += __shfl_xor(ss, 16);
      const float rs = rsqrtf(ss * (1.0f / 128.0f) + RMS_EPS);
      bf16* op = CB + (size_t)(qrow0 + crow(r, hi)) * DM + 256 + h * 128 + r32;
#pragma unroll
      for (int d0 = 0; d0 < 4; ++d0) op[d0 * 32] = (bf16)f2bf(o[d0][r] * rs * g4[d0]); }
  }
#undef SLOAD
#undef SWRITE
#undef SWAIT
#undef RESC
#undef SYNC
#undef PSM
#undef FSM
#undef PVD
#undef PV_PSM
}

__device__ __forceinline__ void diff_unit_dma2(const Frame& F, int l, int b, int h, int qb) {
  const bf16* Z = (const bf16*)(F.ws + WS_ZB); bf16* CB = (bf16*)(F.ws + WS_CB);
  const int wid = F.wave, lane = F.lane, r32 = lane & 31, hi = lane >> 5, map = wid >> 2, qs = wid & 3;
  LAS char* lds = (LAS char*)F.lds;
  LAS char* V_lds = lds; LAS char* K_lds = lds + 4 * SHM_V;
  LAS float* wsf = (LAS float*)(lds + 4 * SHM_V + 3 * SHM_K) + wid * 64; LAS float* li_l = wsf; LAS float* al_l = wsf + 32;
  const int brow0 = b * RPB, qrow0 = brow0 + CTX + qb * 128 + qs * 32;
  float m_reg = 0.f, l_reg = 0; f32x16 o[4] = {}; f32x16 negm = {}; bf16x8 qr[4];
  const bf16* Qw = Z + (size_t)(qrow0 + r32) * NZ + ZDQ + h * 128 + map * 64 + hi * 8;
#pragma unroll
  for (int d0 = 0; d0 < 4; ++d0) qr[d0] = *(const bf16x8*)(Qw + d0 * 16);
  const bf16* Kh = Z + (size_t)brow0 * NZ + ZDK + h * 128; const bf16* Vh = Z + (size_t)brow0 * NZ + ZDV + h * 128;
  const int vb0 = (int)(unsigned)(uintptr_t)V_lds + v_rd_base(lane);
  unsigned ksrc[2], vsrc[2];
#pragma unroll
  for (int i = 0; i < 2; ++i) { const int pc = wid * 2 + i; const int krow = pc * 4 + (lane >> 4), kch = (lane & 15) ^ (krow & 7); ksrc[i] = (unsigned)(krow * NZ + kch * 8);
    const int st = pc * 2 + (lane >> 5), slot = lane & 31, kk = (st >> 2) * 8 + (slot >> 2), kq = (kk & ~0xC) | ((kk & 4) << 1) | ((kk & 8) >> 1), cc = (st & 3) * 32 + (slot & 3) * 8;
    vsrc[i] = (unsigned)(kq * NZ + cc); }
  constexpr int NT = NCH;
#define DMA_TILE(t, kb_, vb_) do { const bf16* kt_ = Kh + (size_t)(t) * 64 * NZ; const bf16* vt_ = Vh + (size_t)(t) * 64 * NZ; const int ks_ = (kb_) * SHM_K + wid * 2048, vs_ = (vb_) * SHM_V + wid * 2048; \
    _Pragma("unroll") for (int i_ = 0; i_ < 2; ++i_) { \
      __builtin_amdgcn_global_load_lds((const GAS unsigned*)(kt_ + ksrc[i_]), (LAS unsigned*)(K_lds + ks_ + i_ * 1024), 16, 0, 0); \
      __builtin_amdgcn_global_load_lds((const GAS unsigned*)(vt_ + vsrc[i_]), (LAS unsigned*)(V_lds + vs_ + i_ * 1024), 16, 0, 0); } } while (0)
#define RBAR() do { asm volatile("s_waitcnt lgkmcnt(0)" ::: "memory"); __builtin_amdgcn_s_barrier(); asm volatile("" ::: "memory"); } while (0)
#define RESC(a) do { if (__any((a) < 1.f)) { if (hi == 0) al_l[r32] = (a); asm volatile("s_waitcnt lgkmcnt(0)" ::: "memory"); \
    _Pragma("unroll") for (int d = 0; d < 4; ++d) _Pragma("unroll") for (int r = 0; r < 16; ++r) o[d][r] *= al_l[crow(r, hi)]; } } while (0)
#define PV_PSM(vb_, P0, P1, MN, AL) do { float pm_; pv_one<0>(o[0], vb_, pa0, pa1, pa2, pa3); pm_ = psm_max(P0, P1); \
    pv_one<1>(o[1], vb_, pa0, pa1, pa2, pa3); psm_decide_r(pm_, m_reg, negm, MN, AL, false); \
    pv_one<2>(o[2], vb_, pa0, pa1, pa2, pa3); psm_sub_r(P0, P1, MN); \
    pv_one<3>(o[3], vb_, pa0, pa1, pa2, pa3); psm_exp0(P0); } while (0)
  f32x16 pA0, pA1, pB0, pB1; float mnA, mnB, alA, alB; bf16x8 pa0, pa1, pa2, pa3;
  asm volatile("s_waitcnt vmcnt(0)" ::: "memory");
  __syncthreads();
  DMA_TILE(0, 0, 0); DMA_TILE(1, 1, 1);
  asm volatile("s_waitcnt vmcnt(4)" ::: "memory"); RBAR();
  qkt_r(pA0, pA1, K_lds, qr, negm, r32, hi, map); { const float pm0 = psm_max(pA0, pA1); psm_decide_r(pm0, m_reg, negm, mnA, alA, true); psm_sub_r(pA0, pA1, mnA); psm_exp0(pA0); }
  DMA_TILE(2, 2, 2);
  asm volatile("s_waitcnt vmcnt(4)" ::: "memory"); RBAR();
  int kj = 1, vj = 1;
#define STEP(PC0, PC1, MNC, ALC, PP0, PP1, ALP, j) do { \
    SBAR(); qkt_r(PC0, PC1, K_lds + kj * SHM_K, qr, negm, r32, hi, map); \
    finishSM(PP0, PP1, ALP, l_reg, pa0, pa1, pa2, pa3); SBAR(); \
    if ((j) + 2 < NT) { const int k2_ = kj == 0 ? 2 : kj - 1, v2_ = (vj + 2) & 3; DMA_TILE((j) + 2, k2_, v2_); } SBAR(); \
    PV_PSM(vb0 + ((vj + 3) & 3) * SHM_V, PC0, PC1, MNC, ALC); \
    RESC(ALC); \
    if ((j) + 2 < NT) asm volatile("s_waitcnt vmcnt(4)" ::: "memory"); else asm volatile("s_waitcnt vmcnt(0)" ::: "memory"); \
    RBAR(); kj = kj == 2 ? 0 : kj + 1; vj = (vj + 1) & 3; } while (0)
  for (int j = 1; j + 1 < NT; j += 2) {
    STEP(pB0, pB1, mnB, alB, pA0, pA1, alA, j);
    STEP(pA0, pA1, mnA, alA, pB0, pB1, alB, j + 1);
  }
  SBAR(); qkt_r(pB0, pB1, K_lds + kj * SHM_K, qr, negm, r32, hi, map);
  finishSM(pA0, pA1, alA, l_reg, pa0, pa1, pa2, pa3); SBAR();
  PV_PSM(vb0 + ((vj + 3) & 3) * SHM_V, pB0, pB1, mnB, alB);
  RESC(alB);
  finishSM(pB0, pB1, alB, l_reg, pa0, pa1, pa2, pa3); SBAR();
  pv_d0(o, vb0 + vj * SHM_V, pa0, pa1, pa2, pa3);
  if (hi == 0) li_l[r32] = l_reg; asm volatile("s_waitcnt lgkmcnt(0)" ::: "memory");
  float rli[16];
#pragma unroll
  for (int r = 0; r < 16; ++r) rli[r] = __builtin_amdgcn_rcpf(li_l[crow(r, hi)]);
  __syncthreads();
  LAS float* X = (LAS float*)lds + qs * 4096 + lane;
  if (map == 1) {
#pragma unroll
    for (int d0 = 0; d0 < 4; ++d0)
#pragma unroll
      for (int r = 0; r < 16; ++r) X[(d0 * 16 + r) * 64] = o[d0][r] * rli[r];
  }
  __syncthreads();
  if (map == 0) {
    const float* LAM = (const float*)(F.ws + WS_SM + SM_LAM); const float lam = LAM[2 * l], li = LAM[2 * l + 1];
    const float* gd = GIN(IN_GDIFF) + l * 128;
    float g4[4];
#pragma unroll
    for (int d0 = 0; d0 < 4; ++d0) g4[d0] = gd[d0 * 32 + r32] * (1.0f - li);
#pragma unroll
    for (int r = 0; r < 16; ++r) { float ss = 0.f;
#pragma unroll
      for (int d0 = 0; d0 < 4; ++d0) { const float v = o[d0][r] * rli[r] - lam * X[(d0 * 16 + r) * 64]; o[d0][r] = v; ss += v * v; }
      ss += __shfl_xor(ss, 1); ss += __shfl_xor(ss, 2); ss += __shfl_xor(ss, 4); ss += __shfl_xor(ss, 8); ss += __shfl_xor(ss, 16);
      const float rs = rsqrtf(ss * (1.0f / 128.0f) + RMS_EPS);
      bf16* op = CB + (size_t)(qrow0 + crow(r, hi)) * DM + 256 + h * 128 + r32;
#pragma unroll
      for (int d0 = 0; d0 < 4; ++d0) op[d0 * 32] = (bf16)f2bf(o[d0][r] * rs * g4[d0]); }
  }
#undef DMA_TILE
#undef RBAR
#undef RESC
#undef PV_PSM
#undef STEP
}
template <bool CTXQ> __device__ __forceinline__ void na_unit_fast(const Frame& F, int l, int b, int hp, int rp) {
  const bf16* Z = (const bf16*)(F.ws + WS_ZB); bf16* CB = (bf16*)(F.ws + WS_CB);
  const int tid = F.tid, wid = F.wave, lane = F.lane, r32 = lane & 31, hi = lane >> 5, hh = wid >> 2, h = hp * 2 + hh;
  const int qrw = 2 * rp + ((wid >> 1) & 1), qc = 32 * (wid & 1) + r32;
  LAS char* lds = (LAS char*)F.lds;
  LAS char* V_lds = lds; LAS char* K_lds = lds + 3 * SHM_V;
  LAS float* wsf = (LAS float*)(lds + 3 * SHM_V + 3 * SHM_K) + wid * 64; LAS float* li_l = wsf; LAS float* al_l = wsf + 32;
  LAS float* rpbl = (LAS float*)(lds + 3 * SHM_V + 3 * SHM_K + 2048);
  const int brow0 = b * RPB, qrow = CTXQ ? brow0 + rp * 128 + (wid & 3) * 32 + r32 : brow0 + CTX + qrw * 64 + qc;
  const int kr0 = min(max(2 * rp - 4, 0), 56), kr1 = min(max(2 * rp - 3, 0), 56) + 7, nt = CTXQ ? 4 : 4 + (kr1 - kr0 + 1);
  const int rs_q = min(max(qrw - 4, 0), 56), cst = min(max(qc - 8, 0), 48);
  float m_reg = -1e30f, l_reg = 0; f32x16 o[2] = {}; bf16x8 qr[4];
  const bf16* Qw = Z + (size_t)qrow * NZ + ZNQ + h * 64 + hi * 8;
#pragma unroll
  for (int d0 = 0; d0 < 4; ++d0) qr[d0] = *(const bf16x8*)(Qw + d0 * 16);
  const bf16* Kh = Z + (size_t)brow0 * NZ + ZNK + hp * 128; const bf16* Vh = Z + (size_t)brow0 * NZ + ZNV + hp * 128;
  const int vb0 = (int)(unsigned)(uintptr_t)V_lds + v_rd_base(lane);
  unsigned ksrc[2], vsrc[2];
#pragma unroll
  for (int i = 0; i < 2; ++i) { const int pc = wid * 2 + i; const int krow = pc * 4 + (lane >> 4), kch = (lane & 15) ^ (krow & 7); ksrc[i] = (unsigned)(krow * NZ + kch * 8);
    const int st = pc * 2 + (lane >> 5), slot = lane & 31, kk = (st >> 2) * 8 + (slot >> 2), kq = (kk & ~0xC) | ((kk & 4) << 1) | ((kk & 8) >> 1), cc = (st & 3) * 32 + (slot & 3) * 8;
    vsrc[i] = (unsigned)(kq * NZ + cc); }
#define TROW(t) (64 * ((t) < 4 ? (t) : 4 + kr0 + (t) - 4))
#define DMA_TILE(t, rb_) do { const bf16* kt_ = Kh + (size_t)TROW(t) * NZ; const bf16* vt_ = Vh + (size_t)TROW(t) * NZ; const int ks_ = (rb_) * SHM_K + wid * 2048, vs_ = (rb_) * SHM_V + wid * 2048; \
    _Pragma("unroll") for (int i_ = 0; i_ < 2; ++i_) { \
      __builtin_amdgcn_global_load_lds((const GAS unsigned*)(kt_ + ksrc[i_]), (LAS unsigned*)(K_lds + ks_ + i_ * 1024), 16, 0, 0); \
      __builtin_amdgcn_global_load_lds((const GAS unsigned*)(vt_ + vsrc[i_]), (LAS unsigned*)(V_lds + vs_ + i_ * 1024), 16, 0, 0); } } while (0)
#define RBAR() do { asm volatile("s_waitcnt lgkmcnt(0)" ::: "memory"); __builtin_amdgcn_s_barrier(); asm volatile("" ::: "memory"); } while (0)
  __syncthreads();
  if (!CTXQ) { const float* rp_g = GIN(IN_RPB) + (size_t)(l * 4 + hp * 2) * 465; for (int i = tid; i < 930; i += 512) rpbl[i] = rp_g[i] * LOG2E; }
  asm volatile("s_waitcnt vmcnt(0)" ::: "memory");
  DMA_TILE(0, 0); if (1 < nt) DMA_TILE(1, 1);
  if (1 < nt) asm volatile("s_waitcnt vmcnt(4)" ::: "memory"); else asm volatile("s_waitcnt vmcnt(0)" ::: "memory");
  RBAR();
  f32x16 p0, p1; float mn, al; bf16x8 pa0, pa1, pa2, pa3;
#define NA_STEP(t, bb) do { \
    const int kr = kr0 + t - 4; const bool active = CTXQ || (t < 4) || (kr >= rs_q && kr <= rs_q + 7); \
    if (active) { \
      qkt(p0, p1, K_lds + bb * SHM_K, qr, r32, hi, hh); \
      if (!CTXQ && t >= 4) { const LAS float* bt = rpbl + hh * 465 + (kr - qrw + 7) * 31 + 15 - qc; \
_Pragma("unroll") \
        for (int r = 0; r < 16; ++r) { const int kc = crow(r, hi); const bool ok0 = (kc >= cst) && (kc < cst + 16), ok1 = (kc + 32 >= cst) && (kc + 32 < cst + 16); \
          p0[r] = ok0 ? p0[r] + bt[kc] : -1.0e30f; p1[r] = ok1 ? p1[r] + bt[kc + 32] : -1.0e30f; } } \
      partialSM(p0, p1, m_reg, mn, al); \
      if (__any(al < 1.f)) { if (hi == 0) al_l[r32] = al; asm volatile("s_waitcnt lgkmcnt(0)" ::: "memory"); \
_Pragma("unroll") \
        for (int d = 0; d < 2; ++d) \
_Pragma("unroll") \
          for (int r = 0; r < 16; ++r) o[d][r] *= al_l[crow(r, hi)]; } \
      finishSM(p0, p1, al, l_reg, pa0, pa1, pa2, pa3); SBAR(); \
      if (hh == 0) { pv_one<0>(o[0], vb0 + bb * SHM_V, pa0, pa1, pa2, pa3); pv_one<1>(o[1], vb0 + bb * SHM_V, pa0, pa1, pa2, pa3); } \
      else { pv_one<2>(o[0], vb0 + bb * SHM_V, pa0, pa1, pa2, pa3); pv_one<3>(o[1], vb0 + bb * SHM_V, pa0, pa1, pa2, pa3); } \
    } \
  } while (0)
  int rb = 0;
  for (int t = 0; t < nt; ++t) {
    if (t + 2 < nt) { const int r2 = rb == 0 ? 2 : rb - 1; DMA_TILE(t + 2, r2); }
    { const int bb = rb; NA_STEP(t, bb); }
    if (t + 2 < nt) asm volatile("s_waitcnt vmcnt(4)" ::: "memory"); else asm volatile("s_waitcnt vmcnt(0)" ::: "memory");
    RBAR(); rb = rb == 2 ? 0 : rb + 1;
  }
#undef NA_STEP
#undef DMA_TILE
#undef RBAR
  if (hi == 0) li_l[r32] = l_reg; asm volatile("s_waitcnt lgkmcnt(0)" ::: "memory");
  bf16* ob = CB + (size_t)(qrow - r32) * DM + 768 + h * 64 + r32;
#pragma unroll
  for (int r = 0; r < 16; ++r) { const float rl = __builtin_amdgcn_rcpf(li_l[crow(r, hi)]); bf16* op = ob + (size_t)crow(r, hi) * DM;
    op[0] = (bf16)f2bf(o[0][r] * rl); op[32] = (bf16)f2bf(o[1][r] * rl); }
#undef TROW
}

__device__ __forceinline__ int qk_off(int row, int k) { return row * 64 + ((((k >> 3) ^ (row >> 2)) & 3) << 4) + (k & 7) * 2; }
__device__ __forceinline__ void gla_c_unit_fast(const Frame& F, int l, int b, int n) {
  const bf16* Z = (const bf16*)(F.ws + WS_ZB); const float* SPg = (const float*)(F.ws + WS_SP); bf16* CB = (bf16*)(F.ws + WS_CB);
  const float* bdec = GIN(IN_BDEC) + l * 256; const float* gg = GIN(IN_GGLA) + l * 64;
  const int tid = F.tid, wid = F.wave, lane = F.lane, r32 = lane & 31, hi = lane >> 5, h = wid >> 1, x = wid & 1;
  LAS char* lds = (LAS char*)F.lds;
  LAS char* QDs = lds; LAS char* KIs = lds + 32768; LAS char* SPt = lds + 65536; LAS char* V_lds = lds + 98304;
  const int base = b * RPB + n * 64;
  const int sr = tid >> 4, sc = (tid & 15) * 8, vst0 = v_st(sr, sc), vst1 = v_st(32 + sr, sc);
  const int dir = x, k = lane & 31, half = lane >> 5;
  const bf16* Vh = Z + (size_t)base * NZ + ZGV;
  const bf16x8 va0 = *(const bf16x8*)&Vh[(size_t)sr * NZ + sc], vc0 = *(const bf16x8*)&Vh[(size_t)(32 + sr) * NZ + sc];
  const bf16x8 va1 = *(const bf16x8*)&Vh[(size_t)sr * NZ + 128 + sc], vc1 = *(const bf16x8*)&Vh[(size_t)(32 + sr) * NZ + 128 + sc];
  const bf16* zp = Z + (size_t)(base + half * 32) * NZ + ZLG + dir * 128 + h * 32 + k;
  const bf16* qp = Z + (size_t)(base + half * 32) * NZ + ZGQ + h * 32 + k; const bf16* kp = Z + (size_t)(base + half * 32) * NZ + ZGK + h * 32 + k;
  const float* sp = SPg + gla_idx(b, dir, h, n) * 2048 + lane;
  bf16 lgv[32], qv[32], kv[32]; float spv[32];
#pragma unroll
  for (int s = 0; s < 32; ++s) lgv[s] = zp[(size_t)s * NZ];
#pragma unroll
  for (int s = 0; s < 32; ++s) { qv[s] = qp[(size_t)s * NZ]; kv[s] = kp[(size_t)s * NZ]; }
#pragma unroll
  for (int s = 0; s < 32; ++s) spv[s] = sp[s * 64];
  const float bd = bdec[dir * 128 + h * 32 + k];
  SBAR();
  __syncthreads();
  *(LAS bf16x8*)(V_lds + vst0) = va0; *(LAS bf16x8*)(V_lds + vst1) = vc0; *(LAS bf16x8*)(V_lds + SHM_V + vst0) = va1; *(LAS bf16x8*)(V_lds + SHM_V + vst1) = vc1;
  {
    float bc[32];
#pragma unroll
    for (int s = 0; s < 32; ++s) bc[s] = log_sigmoid_f(bf2f(lgv[s]) + bd) * (1.0f / 16.0f);
    float tot = 0.f;
#pragma unroll
    for (int s = 0; s < 32; ++s) tot += bc[s];
    const float other = __shfl_xor(tot, 32);
    if (dir == 0) { float run = half ? other : 0.f;
#pragma unroll
      for (int s = 0; s < 32; ++s) { run += bc[s]; bc[s] = run; } }
    else { float run = half ? 0.f : other;
#pragma unroll
      for (int s = 31; s >= 0; --s) { run += bc[s]; bc[s] = run; } }
    LAS char* qd = QDs + (h * 2 + dir) * 4096; LAS char* ki = KIs + (h * 2 + dir) * 4096;
#pragma unroll
    for (int s = 0; s < 32; ++s) { const float e = __expf(bc[s]); const int off = qk_off(half * 32 + s, k);
      *(LAS bf16*)(qd + off) = (bf16)f2bf(bf2f(qv[s]) * e); *(LAS bf16*)(ki + off) = (bf16)f2bf(bf2f(kv[s]) * __builtin_amdgcn_rcpf(e)); }
    LAS char* st = SPt + (h * 2 + dir) * 4096;
#pragma unroll
    for (int c8 = 0; c8 < 4; ++c8) { u32x4 w;
      w.x = pk2(spv[c8 * 8 + 0], spv[c8 * 8 + 1]); w.y = pk2(spv[c8 * 8 + 2], spv[c8 * 8 + 3]); w.z = pk2(spv[c8 * 8 + 4], spv[c8 * 8 + 5]); w.w = pk2(spv[c8 * 8 + 6], spv[c8 * 8 + 7]);
      *(LAS u32x4*)(st + lane * 64 + (((c8 ^ (lane >> 2)) & 3) << 4)) = w; }
  }
  __syncthreads();
  {
    const int cb = x, crow_q = 32 * cb + r32; f32x16 o[2] = {};
    bf16 gt0[16], gt1[16];
#pragma unroll
    for (int r = 0; r < 16; ++r) { const bf16* gp_ = Z + (size_t)(base + 32 * cb + crow(r, hi)) * NZ + ZGG + h * 64 + r32; gt0[r] = gp_[0]; gt1[r] = gp_[32]; }
    SBAR();
    const int vb = (int)(unsigned)(uintptr_t)V_lds + (h >> 1) * SHM_V + v_rd_base(lane);
#pragma unroll
    for (int dir = 0; dir < 2; ++dir) {
      const LAS char* qd = QDs + (h * 2 + dir) * 4096; const LAS char* ki = KIs + (h * 2 + dir) * 4096; const LAS char* st = SPt + (h * 2 + dir) * 4096;
      bf16x8 qf[2]; f32x16 p0 = {}, p1 = {};
#pragma unroll
      for (int ks = 0; ks < 2; ++ks) { qf[ks] = *(const LAS bf16x8*)(qd + qk_off(crow_q, ks * 16 + hi * 8));
        const bf16x8 b0 = *(const LAS bf16x8*)(ki + qk_off(r32, ks * 16 + hi * 8)), b1 = *(const LAS bf16x8*)(ki + qk_off(32 + r32, ks * 16 + hi * 8));
        p0 = __builtin_amdgcn_mfma_f32_32x32x16_bf16(b0, qf[ks], p0, 0, 0, 0); p1 = __builtin_amdgcn_mfma_f32_32x32x16_bf16(b1, qf[ks], p1, 0, 0, 0); }
#pragma unroll
      for (int r = 0; r < 16; ++r) { const int s0 = crow(r, hi), s1 = 32 + s0;
        const bool k0 = dir == 0 ? (s0 <= crow_q) : (s0 >= crow_q), k1 = dir == 0 ? (s1 <= crow_q) : (s1 >= crow_q);
        p0[r] = k0 ? p0[r] : 0.f; p1[r] = k1 ? p1[r] : 0.f; }
      bf16x8 pa0, pa1, pa2, pa3;
#define PK4(P, BASE, OUT) do { unsigned a0 = cvtpk(P[BASE + 0], P[BASE + 1]), a1 = cvtpk(P[BASE + 2], P[BASE + 3]);   \
    unsigned b0_ = cvtpk(P[BASE + 4], P[BASE + 5]), b1_ = cvtpk(P[BASE + 6], P[BASE + 7]);                              \
    auto r0 = __builtin_amdgcn_permlane32_swap(a0, b0_, false, false); auto r1 = __builtin_amdgcn_permlane32_swap(a1, b1_, false, false); \
    u32x4 w = {r0[0], r1[0], r0[1], r1[1]}; OUT = __builtin_bit_cast(bf16x8, w); } while (0)
      PK4(p0, 0, pa0); PK4(p0, 8, pa1); PK4(p1, 0, pa2); PK4(p1, 8, pa3);
#undef PK4
      SBAR();
      if (h & 1) { pv_one<2>(o[0], vb, pa0, pa1, pa2, pa3); pv_one<3>(o[1], vb, pa0, pa1, pa2, pa3); }
      else { pv_one<0>(o[0], vb, pa0, pa1, pa2, pa3); pv_one<1>(o[1], vb, pa0, pa1, pa2, pa3); }
#pragma unroll
      for (int vbk = 0; vbk < 2; ++vbk)
#pragma unroll
        for (int ks = 0; ks < 2; ++ks) { const bf16x8 sf = *(const LAS bf16x8*)(st + qk_off(vbk * 32 + r32, ks * 16 + hi * 8));
          o[vbk] = __builtin_amdgcn_mfma_f32_32x32x16_bf16(qf[ks], sf, o[vbk], 0, 0, 0); }
    }
    const float g0 = gg[r32], g1 = gg[32 + r32];
#pragma unroll
    for (int r = 0; r < 16; ++r) { const int c = 32 * cb + crow(r, hi); float ss = o[0][r] * o[0][r] + o[1][r] * o[1][r];
      ss += __shfl_xor(ss, 1); ss += __shfl_xor(ss, 2); ss += __shfl_xor(ss, 4); ss += __shfl_xor(ss, 8); ss += __shfl_xor(ss, 16);
      const float rs = rsqrtf(ss * (1.0f / 64.0f) + RMS_EPS);
      bf16* op = CB + (size_t)(base + c) * DM + h * 64 + r32;
      op[0] = (bf16)f2bf(o[0][r] * rs * g0 * silu_f(bf2f(gt0[r]))); op[32] = (bf16)f2bf(o[1][r] * rs * g1 * silu_f(bf2f(gt1[r]))); }
  }
}
#undef KSWZ
#undef SBAR
}
__device__ __forceinline__ void phase_mixer(const Frame& F, int l) {
    const bool ctxo = (l == 0);
    { const bool xa = (F.G & 7) == 0; const int c = (int)blockIdx.x, per = F.G >> 3;
      for (int u = c, i = 0; u < NB * 4 * 32; u += F.G, ++i) { const int sq = i * per + (c >> 3); const int pr = xa ? (c & 7) + 8 * (sq >> 5) : (u >> 5), qb = xa ? (sq & 31) : (u & 31);
          dat::diff_unit_dma2(F, l, pr >> 2, pr & 3, qb); }
      for (int u = c, i = 0; u < NB * 2 * 32; u += F.G, ++i) { const int sq = i * per + (c >> 3); const int pr = xa ? (c & 7) + 8 * (sq >> 5) : (u >> 5), rp = xa ? (sq & 31) : (u & 31);
          dat::na_unit_fast<false>(F, l, pr >> 1, pr & 1, rp); } }
    const int c2 = (int)((blockIdx.x + F.G - (128 % F.G)) % F.G);
    for (int u = c2; u < NB * NCH; u += F.G) { const int n = u % NCH, b = u / NCH; if (n >= 4 || ctxo) dat::gla_c_unit_fast(F, l, b, n); }
    if (ctxo) {
        for (int u = blockIdx.x; u < NB * 4 * 2; u += F.G) { const int qb = u & 1, h = (u >> 1) & 3, b = u >> 3; dat::diff_unit_fast<true>(F, l, b, h, qb); }
        const int c3 = (int)((blockIdx.x + F.G - (64 % F.G)) % F.G);
        for (int u = c3; u < NB * 2 * 2; u += F.G) { const int qb = u & 1, hp = (u >> 1) & 1, b = u >> 2; dat::na_unit_fast<true>(F, l, b, hp, qb); }
    }
}
#ifndef MK_MULTI
#define MK_MULTI 0
#endif
constexpr int NPH = 21;
constexpr int MOE_SPLIT = MOE_ITEMS / 3, MOE_SPLIT2 = MOE_SPLIT + MOE_ITEMS / 2;
#define TAIL_CONVERT(nunits, it_lo, it_hi) do { const int nfull_ = (nunits) % F.G, c_ = (int)blockIdx.x; \
    if (nfull_ == 0) moe_convert_items(F, it_lo, it_hi, c_, F.G); else if (c_ >= nfull_) moe_convert_items(F, it_lo, it_hi, c_ - nfull_, F.G - nfull_); } while (0)
__global__ void __launch_bounds__(512, 2) fwd(Args a) {
    extern __shared__ __attribute__((aligned(16))) unsigned char lds_raw[];
    Frame F;
    F.lds = (LAS unsigned char*)lds_raw;
    F.tid = threadIdx.x; F.lane = F.tid & 63; F.wave = __builtin_amdgcn_readfirstlane(F.tid >> 6); F.G = gridDim.x;
    F.gw = blockIdx.x * 8 + F.wave; F.ngw = F.G * 8;
    F.ap = (CArgs*)__builtin_amdgcn_kernarg_segment_ptr();
    F.out = (GAS float*)a.out; F.ws = (GAS unsigned char*)a.ws;
    volatile LAS unsigned* MISC = (volatile LAS unsigned*)(F.lds + MISC_OFF);
    if (F.tid < 32) MISC[F.tid] = 0u;
    __syncthreads();
    unsigned* ctl = (unsigned*)(F.ws + WS_CTL);
    XcdBarrier bar; bar.bar = ctl + CW_BAR; bar.x = 0; bar.st = nullptr;
    if (!MK_MULTI) bar = xcd_barrier_post(ctl + CW_BAR, MISC + 8);
    const int lo = a.ph_lo, hi = a.ph_hi;
#ifndef PH_MASK
#define PH_MASK 0x1fffffu
#endif
#define IN(k) (((PH_MASK >> (k)) & 1u) && lo <= (k) && (k) < hi)
#define LAUNDER() do { CArgs* p_ = F.ap; GAS unsigned char* w_ = F.ws; GAS float* o_ = F.out; asm volatile("" : "+s"(p_), "+s"(w_), "+s"(o_)); F.ap = p_; F.ws = w_; F.out = o_; } while (0)
#define SEAM(k) do { if (!MK_MULTI && IN(k) && IN((k) + 1)) xcd_barrier(bar); else __syncthreads(); } while (0)
#define HB ((const pg8::bf16_t*)(F.ws + WS_HB))
#define XC ((float*)(F.ws + WS_XC))

    if (IN(0)) { LAUNDER(); phase_prologue(F); } SEAM(0);
    if (IN(1)) { LAUNDER(); phase_transposes_rest(F); phase_norm(F, 0, 0, GIN(IN_X), GIN(IN_CTX)); } SEAM(1);
#define LAYER_FRONT(l, pb) do { \
        if (IN(pb)) { LAUNDER(); \
            pg8::Gemm g{HB, (const pg8::bf16_t*)(F.ws + (l ? W_IN1 : W_IN0)), DM, nullptr, 0}; \
            pg8::RowOrder S{NROW / 256, NZ / 256, F.G, (int)blockIdx.x, DM, false}; \
            if (l) { pg8::stage_norm_tables(F.lds, (const float*)(F.ws + WS_SS), (const float*)(F.ws + WS_SM + SM_SWIN), NZ, S); \
                pg8::EpiProj<true> E{(pg8::bf16_t*)(F.ws + WS_ZB), NZ, (const LAS float*)(F.lds + pg8::GROWS_OFF), (const float*)(F.ws + WS_SM + SM_ROPE)}; \
                pg8::gemm_phase<pg8::EpiProj<true>, pg8::RowOrder, true, false>(F.lds, g, S, E); } \
            else { pg8::EpiProj<false> E{(pg8::bf16_t*)(F.ws + WS_ZB), NZ, (const LAS float*)(F.lds + pg8::GROWS_OFF), (const float*)(F.ws + WS_SM + SM_ROPE)}; \
                pg8::gemm_phase<pg8::EpiProj<false>, pg8::RowOrder, true, false>(F.lds, g, S, E); } \
        } SEAM(pb); \
        if (IN(pb + 1)) { LAUNDER(); phase_gla_a(F, l); if (!l) phase_shiftw(F); } SEAM(pb + 1); \
        if (IN(pb + 2)) { LAUNDER(); phase_gla_scan(F); } SEAM(pb + 2); \
        if (IN(pb + 3)) { LAUNDER(); phase_mixer(F, l); } SEAM(pb + 3); \
        if (IN(pb + 4)) { LAUNDER(); const void* xl2 = l ? (const void*)F.out : (const void*)GIN(IN_X); const void* xc2 = l ? (const void*)(F.ws + WS_XC) : (const void*)GIN(IN_CTX); \
            pg8::Gemm g{(const pg8::bf16_t*)(F.ws + WS_CB), (const pg8::bf16_t*)(F.ws + (l ? W_OUT1 : W_OUT0)), DM, nullptr, 0}; \
            pg8::RowOrder S{l ? NLAT / 256 : NROW / 256, DM / 256, F.G, (int)blockIdx.x, DM, l != 0}; \
            if (l) { pg8::EpiRes<false, false> E{xl2, xc2, (pg8::bf16_t*)F.out, (pg8::bf16_t*)(F.ws + WS_XC), (const float*)(F.ws + WS_SM) + (size_t)l * 9 * 6144 + 2048, nullptr, nullptr, nullptr, nullptr}; \
                pg8::gemm_phase<pg8::EpiRes<false, false>, pg8::RowOrder, true, false>(F.lds, g, S, E); } \
            else {     \
                pg8::EpiRes<true, true> E{xl2, xc2, (pg8::bf16_t*)F.out, (pg8::bf16_t*)(F.ws + WS_XC), (const float*)(F.ws + WS_SM) + 2048, \
                                 GIN(IN_GN2), (const float*)(F.ws + WS_SM) + 3072 + 1024, (pg8::bf16_t*)(F.ws + WS_XS), (float*)(F.ws + WS_SS)}; \
                pg8::gemm_phase<pg8::EpiRes<true, true>, pg8::RowOrder, true, false>(F.lds, g, S, E); \
                TAIL_CONVERT(NROW / 256 * (DM / 256), 0, MOE_SPLIT); } \
        } SEAM(pb + 4); } while (0)
#define MOE_PASS(p) do { \
        if (IN(16 + 2 * p)) { LAUNDER(); int tb[8], cnt[8]; const int T = moe_tiles(F, tb, cnt); \
            const int tile0 = p * PASS0_TILES, nM = p ? (T > PASS0_TILES ? T - PASS0_TILES : 0) : (T < PASS0_TILES ? T : PASS0_TILES); \
            pg8::Gemm g{HB, (const pg8::bf16_t*)(F.ws + WS_MW), DM, (const int*)(F.ws + WS_ML + ML_ROWLIST), 0}; \
            pg8::MoeOrder S; S.nM = nM; S.nN = 2 * FFE / 256; S.G = F.G; S.c = (int)blockIdx.x; S.K = DM; S.tile0 = tile0; S.estride = (long)MW_STRIDE; \
            _Pragma("unroll") for (int k = 0; k < 8; ++k) S.tb[k] = tb[k]; \
            pg8::EpiSwiglu E{(pg8::bf16_t*)(F.ws + WS_AB), FFE}; \
            pg8::stage_gather_rows(F.lds, g.rows, S); \
            pg8::gemm_phase<pg8::EpiSwiglu, pg8::MoeOrder, true, true>(F.lds, g, S, E); \
        } SEAM(16 + 2 * p); \
        if (IN(17 + 2 * p)) { LAUNDER(); int tb[8], cnt[8]; const int T = moe_tiles(F, tb, cnt); \
            const int Tn = T < 256 ? T : 256; const int tile0 = p * PASS0_TILES, nM = p ? (Tn > PASS0_TILES ? Tn - PASS0_TILES : 0) : (Tn < PASS0_TILES ? Tn : PASS0_TILES); \
            pg8::Gemm g{(const pg8::bf16_t*)(F.ws + WS_AB), (const pg8::bf16_t*)(F.ws + WS_MW + MW_DN), FFE, nullptr, 0}; \
            pg8::MoeOrder S; S.nM = nM; S.nN = DM / 256; S.G = F.G; S.c = (int)blockIdx.x; S.K = FFE; S.tile0 = tile0; S.estride = (long)MW_STRIDE; \
            _Pragma("unroll") for (int k = 0; k < 8; ++k) S.tb[k] = tb[k]; \
            pg8::EpiBf16 E{(pg8::bf16_t*)(F.ws + (p ? WS_HB : WS_YB0)), DM, 0}; \
            pg8::gemm_phase<pg8::EpiBf16, pg8::MoeOrder, true, false>(F.lds, g, S, E); \
            if (p == 1 && T > 256) {     \
                __syncthreads(); \
                pg8::Gemm g2{(const pg8::bf16_t*)(F.ws + WS_AB) + (size_t)(256 - PASS0_TILES) * 256 * FFE, (const pg8::bf16_t*)(F.ws + WS_MW + MW_DN), FFE, nullptr, FFE / YX_KS}; \
                pg8::MoeSplitOrder S2; S2.nM = T - 256; S2.nN = DM / 256; S2.KS = YX_KS; S2.G = F.G; S2.c = (int)blockIdx.x; S2.K = FFE; S2.Kloop = FFE / YX_KS; S2.tile0 = 256; S2.estride = (long)MW_STRIDE; \
                _Pragma("unroll") for (int k = 0; k < 8; ++k) S2.tb[k] = tb[k]; \
                pg8::EpiBf16 E2{(pg8::bf16_t*)(F.ws + WS_YX), DM, YX_SLAB}; \
                pg8::gemm_phase<pg8::EpiBf16, pg8::MoeSplitOrder, true, false>(F.lds, g2, S2, E2); } \
        } SEAM(17 + 2 * p); } while (0)
    LAYER_FRONT(0, 2);
    if (IN(7)) { LAUNDER();
        pg8::Gemm g{(const pg8::bf16_t*)(F.ws + WS_XS), (const pg8::bf16_t*)(F.ws + W_GU), DM, nullptr, 0};
        pg8::RowOrder S{NROW / 256, 2 * FFD / 256, F.G, (int)blockIdx.x, DM, false};
        pg8::stage_norm_tables(F.lds, (const float*)(F.ws + WS_SS), (const float*)(F.ws + WS_SM + SM_SWGU), 2 * FFD, S);
        pg8::EpiSwigluN E{(pg8::bf16_t*)(F.ws + WS_ZB), FFD, (const LAS float*)(F.lds + pg8::GROWS_OFF)};
        pg8::gemm_phase<pg8::EpiSwigluN, pg8::RowOrder, true, false>(F.lds, g, S, E);
    } SEAM(7);
    if (IN(8)) { LAUNDER();
        pg8::Gemm g{(const pg8::bf16_t*)(F.ws + WS_ZB), (const pg8::bf16_t*)(F.ws + W_DN), FFD, nullptr, 0};
        pg8::RowOrder S{NROW / 256, DM / 256, F.G, (int)blockIdx.x, FFD, false};
        pg8::EpiRes<false, true> E{(const void*)F.out, (const void*)(F.ws + WS_XC), (pg8::bf16_t*)F.out, (pg8::bf16_t*)(F.ws + WS_XC), (const float*)(F.ws + WS_SM) + 5120,
                         GIN(IN_GN1) + DM, (const float*)(F.ws + WS_SM) + (size_t)9 * 6144 + 1024, (pg8::bf16_t*)(F.ws + WS_HB), (float*)(F.ws + WS_SS)};
        pg8::gemm_phase<pg8::EpiRes<false, true>, pg8::RowOrder, true, false>(F.lds, g, S, E);
        TAIL_CONVERT(NROW / 256 * (DM / 256), MOE_SPLIT, MOE_SPLIT2);
    } SEAM(8);
    LAYER_FRONT(1, 9);
    if (IN(14)) { LAUNDER(); phase_norm_router(F, (const float*)F.out); } SEAM(14);
    if (IN(15)) { LAUNDER(); phase_moe_prep(F); moe_convert_items(F, MOE_SPLIT2, MOE_ITEMS, (int)blockIdx.x, F.G); } SEAM(15);
    MOE_PASS(0);
    MOE_PASS(1);
    if (IN(20)) { LAUNDER(); phase_final(F); }
#undef LAYER_FRONT
#undef MOE_PASS
#undef IN
#undef SEAM
#undef HB
#undef XC
}

extern "C" void kernel_launch(void* const* d_in, const int* in_sizes, int n_in, void* d_out, int out_size, void* d_ws, size_t ws_size, hipStream_t stream) {
    static int grid = 0;
    if (grid == 0) {
        if (n_in != 24 || out_size != NLAT * DM || ws_size < WS_END) { fprintf(stderr, "kernel_launch: unexpected shapes (n_in %d out %d ws %zu)\n", n_in, out_size, ws_size); grid = -1; return; }
        int dev = 0, cus = 0, per_cu = 0;
        if (hipGetDevice(&dev) != hipSuccess || hipDeviceGetAttribute(&cus, hipDeviceAttributeMultiprocessorCount, dev) != hipSuccess) { grid = -1; return; }
        if (hipFuncSetAttribute((const void*)fwd, hipFuncAttributeMaxDynamicSharedMemorySize, LDS_BYTES) != hipSuccess) { fprintf(stderr, "kernel_launch: hipFuncSetAttribute failed\n"); grid = -1; return; }
        if (hipOccupancyMaxActiveBlocksPerMultiprocessor(&per_cu, (const void*)fwd, 512, LDS_BYTES) != hipSuccess || per_cu < 1) fprintf(stderr, "kernel_launch: occupancy query says %d\n", per_cu);
        (void)hipGetLastError();
        grid = cus;
    }
    if (grid < 0) return;
    (void)hipMemsetAsync((char*)d_ws + WS_CTL, 0, CTL_ZERO_BYTES, stream);
    Args a{};
    for (int i = 0; i < 24; ++i) a.in[i] = (const float*)d_in[i];
    a.out = (float*)d_out; a.ws = (unsigned char*)d_ws;
#if MK_MULTI
    for (int p = 0; p < NPH; ++p) { a.ph_lo = p; a.ph_hi = p + 1; hipLaunchKernelGGL(fwd, dim3(grid), dim3(512), LDS_BYTES, stream, a); }
#else
    a.ph_lo = 0; a.ph_hi = NPH; hipLaunchKernelGGL(fwd, dim3(grid), dim3(512), LDS_BYTES, stream, a);
#endif
}
```

```cpp
#include <hip/hip_runtime.h>
#include <cstdio>
#include <cstdint>

#define LAS __attribute__((address_space(3)))
#define GAS __attribute__((address_space(1)))
typedef unsigned short bf16;
typedef short bf16x8 __attribute__((ext_vector_type(8)));
typedef float f32x4 __attribute__((ext_vector_type(4)));
typedef float f32x2 __attribute__((ext_vector_type(2)));
typedef unsigned u32x4 __attribute__((ext_vector_type(4)));
typedef unsigned u32x2 __attribute__((ext_vector_type(2)));

constexpr int NB = 8, SEQ = 4096, CTX = 256, DM = 1024, RPB = CTX + SEQ, NROW = NB * RPB;
constexpr int NLAT = NB * SEQ;
constexpr int NZ = 3328;
constexpr int ZGQ = 0, ZGK = 128, ZGV = 256, ZGG = 512, ZDQ = 768, ZDK = 1280, ZDV = 1792, ZNQ = 2304, ZNK = 2560, ZNV = 2816, ZLG = 3072;
constexpr int FFD = 2816, FFE = 3584, NEXP = 8;
constexpr int NCH = RPB / 64;
constexpr float RMS_EPS = 1e-6f;
constexpr float LOG2E = 1.4426950408889634f;
constexpr float QSCALE = 0.125f * LOG2E;
constexpr int PASS0_TILES = 128, PASS1_MAX = 136;

constexpr size_t MiB = 1u << 20;
constexpr size_t WS_CTL = 0, CTL_ZERO_BYTES = 65536;
constexpr size_t WS_SM = 1 * MiB;
constexpr size_t SM_ROPE = 448 * 1024, SM_LAM = 460 * 1024;
constexpr size_t SM_SWGU = 480 * 1024, SM_SWIN = 704 * 1024;
constexpr size_t WS_XS = 503 * MiB, WS_SS = 571 * MiB;
constexpr size_t WS_ML = 2 * MiB;
constexpr size_t ML_TOKINFO = 1 * MiB, ML_ROWLIST = 1536 * 1024;
constexpr size_t WS_XC = 4 * MiB;
constexpr size_t WS_HB = 12 * MiB;
constexpr size_t WS_CB = WS_HB;
constexpr size_t WS_MW = 80 * MiB;
constexpr size_t MW_STRIDE = 21 * MiB, MW_DN = 14 * MiB;
constexpr size_t WS_W = 248 * MiB;
constexpr size_t W_IN0 = WS_W, W_IN1 = WS_W + 6656 * 1024, W_OUT0 = WS_W + 13 * MiB, W_OUT1 = WS_W + 15 * MiB, W_GU = WS_W + 17 * MiB, W_DN = WS_W + 28 * MiB;
constexpr size_t WS_ZB = 282 * MiB;
constexpr size_t WS_U = 503 * MiB, WS_SP = 537 * MiB, WS_BE = 571 * MiB;
constexpr size_t WS_AB = 282 * MiB;
constexpr size_t WS_YB0 = 520 * MiB;
constexpr size_t WS_END = 584 * MiB;
static_assert(WS_HB + (size_t)NROW * DM * 2 <= WS_MW && WS_MW + 8 * MW_STRIDE <= WS_W && W_DN + (size_t)DM * FFD * 2 <= WS_ZB && WS_ZB + (size_t)NROW * NZ * 2 <= WS_U, "ws map");
static_assert(WS_U + (size_t)NB * 2 * 4 * NCH * 2048 * 4 <= WS_SP && WS_SP + (size_t)NB * 2 * 4 * NCH * 2048 * 4 <= WS_BE && WS_BE + (size_t)NB * 2 * 4 * NCH * 32 * 4 <= WS_END, "ws map gla");
static_assert(WS_AB + (size_t)PASS1_MAX * 256 * FFE * 2 <= WS_YB0 && WS_YB0 + (size_t)PASS0_TILES * 256 * DM * 2 <= WS_END && (size_t)PASS1_MAX * 256 * DM * 2 <= (size_t)NROW * DM * 2, "ws map moe");
static_assert(WS_ZB + (size_t)NROW * FFD * 2 <= WS_U, "dense activation overlay");
constexpr int CW_TMO = 0, CW_BAR = 4096, CW_CNT = 8192;
static_assert((CW_CNT + 64 * 8) * 4 <= (int)CTL_ZERO_BYTES && (CW_BAR + 3456) <= CW_CNT, "control words inside the memset region");

constexpr int RING_BYTES = 131072, MISC_OFF = RING_BYTES + 320, LDS_BYTES = 163840;

__device__ __forceinline__ float bf2f(bf16 v) { return __uint_as_float(((unsigned)v) << 16); }
__device__ __forceinline__ unsigned f2bf(float f) { unsigned u = __float_as_uint(f); return (u + 0x7fffu + ((u >> 16) & 1u)) >> 16; }
__device__ __forceinline__ unsigned pk2(float lo, float hi) { return f2bf(lo) | (f2bf(hi) << 16); }
__device__ __forceinline__ float wave_sum(float v) {
#pragma unroll
    for (int o = 1; o < 64; o <<= 1) v += __shfl_xor(v, o);
    return v;
}
__device__ __forceinline__ float silu_f(float x) { return x / (1.0f + __expf(-x)); }

namespace pg8 {
#define PG8_LAS __attribute__((address_space(3)))
typedef unsigned short bf16_t;
constexpr int BM = 256, BK = 64, HALF = 128, HTB = HALF * BK * 2, STAGE_BYTES = 8 * HTB, NXCD = 8, WGM = 8;
constexpr int GROWS_OFF = 131520, GROWS_MAX = 15;
__host__ __device__ __forceinline__ int lds_byte(int r, int c) { const int st = (r >> 4) * 2 + (c >> 5), rr = r & 15, cc = c & 31, ob = rr * 64 + cc * 2; return st * 1024 + (ob ^ (((ob >> 9) & 1) << 5)); }
__host__ __device__ __forceinline__ void stage_rc(int b, int& R, int& C) { const int st = b / 1024, sb = b % 1024, swz = sb ^ (((sb >> 9) & 1) << 5); R = (st >> 1) * 16 + swz / 64; C = (st & 1) * 32 + (swz % 64) / 2; }
__host__ __device__ __forceinline__ int perm32(int rho) { const int n = rho >> 4, i = rho & 15; return 8 * (i >> 2) + 4 * n + (i & 3); }

struct Unit { int pm, pn, ga; long bo; long ko; int ks; int sl; };
struct Gemm { const bf16_t* A; const bf16_t* Bt; int K; const int* rows; int Kloop; };

__device__ __forceinline__ bool tile_order(int i, int G, int c, int nM, int nN, int& pm, int& pn) {
    const int nwg = nM * nN; const long L = (long)i * G + c; if (L >= nwg) return false;
    int wgid = (int)L; { const int q = nwg / NXCD, r = nwg % NXCD, xcd = wgid % NXCD, off = wgid / NXCD; wgid = (xcd < r ? xcd * (q + 1) : r * (q + 1) + (xcd - r) * q) + off; }
    const int nig = WGM * nN, gid = wgid / nig, fm = gid * WGM, gsz = (nM - fm) < WGM ? (nM - fm) : WGM;
    pm = fm + ((wgid % nig) % gsz); pn = (wgid % nig) / gsz; return true;
}
struct RowOrder {
    int nM, nN, G, c, K; bool skipctx;
    __device__ __forceinline__ bool next(int i, Unit& u) const {
        int pm, pn; if (!tile_order(i, G, c, nM, nN, pm, pn)) return false;
        u.pm = skipctx ? 17 * (pm >> 4) + 1 + (pm & 15) : pm; u.pn = pn; u.ga = 0; u.bo = (long)pn * 256 * K * 2; u.ko = 0; u.ks = 0; u.sl = i; return true;
    }
};
struct MoeOrder {
    int nM, nN, G, c, K, tile0; int tb[8]; long estride;
    __device__ __forceinline__ bool next(int i, Unit& u) const {
        int pm, pn; if (!tile_order(i, G, c, nM, nN, pm, pn)) return false;
        u.pm = pm; u.pn = pn; u.ga = tile0 + pm; int e = 0;
#pragma unroll
        for (int k = 1; k < 8; ++k) e += (u.ga >= tb[k]) ? 1 : 0;
        u.bo = (long)e * estride + (long)pn * 256 * K * 2; u.ko = 0; u.ks = 0; u.sl = i; return true;
    }
};
struct MoeSplitOrder {
    int nM, nN, KS, G, c, K, Kloop, tile0; int tb[8]; long estride;
    __device__ __forceinline__ bool next(int i, Unit& u) const {
        const long L = (long)i * G + c; if (L >= (long)nM * nN * KS) return false;
        const int ks = (int)(L % KS), r = (int)(L / KS); u.pn = r % nN; u.pm = r / nN; u.ga = tile0 + u.pm; int e = 0;
#pragma unroll
        for (int k = 1; k < 8; ++k) e += (u.ga >= tb[k]) ? 1 : 0;
        u.bo = (long)e * estride + (long)u.pn * 256 * K * 2; u.ko = (long)ks * Kloop * 2; u.ks = ks; u.sl = i; return true;
    }
};

__device__ __forceinline__ unsigned cvt_pk_bf16(float lo, float hi) { unsigned r; asm volatile("v_cvt_pk_bf16_f32 %0, %1, %2" : "=v"(r) : "v"(lo), "v"(hi)); return r; }

struct EpiBf16 {
    static constexpr bool PERM = true;
    bf16_t* O; int ldc; size_t slab;
    __device__ __forceinline__ void operator()(const f32x4 (&acc)[2][2][4][2], const Unit& u, int wr, int wc, int fr, int fq) const {
        const int row0 = u.pm * BM + wr * 64 + fr, col0 = u.pn * BM + wc * 32 + 8 * fq; bf16_t* Ob = O + (size_t)u.ks * slab;
#pragma unroll
        for (int ai = 0; ai < 2; ++ai)
#pragma unroll
            for (int m = 0; m < 4; ++m) { bf16_t* rowp = Ob + (size_t)(row0 + ai * HALF + m * 16) * ldc + col0;
#pragma unroll
                for (int bj = 0; bj < 2; ++bj) { const f32x4 v0 = acc[ai][bj][m][0], v1 = acc[ai][bj][m][1];
                    u32x4 w; w.x = cvt_pk_bf16(v0[0], v0[1]); w.y = cvt_pk_bf16(v0[2], v0[3]); w.z = cvt_pk_bf16(v1[0], v1[1]); w.w = cvt_pk_bf16(v1[2], v1[3]);
                    *(u32x4*)(rowp + bj * HALF) = w; } }
    }
};
struct EpiSwiglu {
    static constexpr bool PERM = true;
    bf16_t* O; int ldc;
    __device__ __forceinline__ void operator()(const f32x4 (&acc)[2][2][4][2], const Unit& u, int wr, int wc, int fr, int fq) const {
        const int row0 = u.pm * BM + wr * 64 + fr, col0 = u.pn * HALF + wc * 32 + 8 * fq;
#pragma unroll
        for (int ai = 0; ai < 2; ++ai)
#pragma unroll
            for (int m = 0; m < 4; ++m) { bf16_t* rowp = O + (size_t)(row0 + ai * HALF + m * 16) * ldc + col0;
                f32x4 v[2];
#pragma unroll
                for (int n = 0; n < 2; ++n) { const f32x4 g = acc[ai][0][m][n], up = acc[ai][1][m][n]; f32x4 t, r;
#pragma unroll
                    for (int j = 0; j < 4; ++j) t[j] = __builtin_amdgcn_exp2f(-g[j]);
                    t = t + 1.0f;
#pragma unroll
                    for (int j = 0; j < 4; ++j) r[j] = __builtin_amdgcn_rcpf(t[j]);
                    v[n] = (g * up) * r; }
                u32x4 w; w.x = cvt_pk_bf16(v[0][0], v[0][1]); w.y = cvt_pk_bf16(v[0][2], v[0][3]); w.z = cvt_pk_bf16(v[1][0], v[1][1]); w.w = cvt_pk_bf16(v[1][2], v[1][3]);
                *(u32x4*)rowp = w; }
    }
};
constexpr int XST = 2 * DM;
template <bool INF32, bool NORM>
struct EpiRes {
    static constexpr bool PERM = true;
    const void* xin_l; const void* xin_c; bf16_t* xout_l; bf16_t* xout_c; const float* ga_base;
    const float* gn; const float* sc_base; bf16_t* XS; float* SS;
    __device__ __forceinline__ void operator()(const f32x4 (&acc)[2][2][4][2], const Unit& u, int wr, int wc, int fr, int fq) const {
        const int b = u.pm / 17, j = u.pm - 17 * b, mrow = j == 0 ? 8 : b;
        const float* ga = ga_base + mrow * 6144; const float* sc = sc_base + mrow * 6144;
        const size_t rbase = j == 0 ? (size_t)b * CTX : (size_t)b * SEQ + (size_t)(j - 1) * 256;
        const float* xif = (const float*)(j == 0 ? xin_c : xin_l) + rbase * DM; const bf16_t* xib = (const bf16_t*)(j == 0 ? xin_c : xin_l) + rbase * XST; bf16_t* xo = (j == 0 ? xout_c : xout_l) + rbase * XST;
        const int row0 = wr * 64 + fr, col0 = u.pn * BM + wc * 32 + 8 * fq;
        f32x4 gv[2][2], gs[2][2];
#pragma unroll
        for (int bj = 0; bj < 2; ++bj)
#pragma unroll
            for (int n = 0; n < 2; ++n) { const int c = col0 + bj * HALF + n * 4; gv[bj][n] = *(const f32x4*)(ga + c); if constexpr (NORM) gs[bj][n] = *(const f32x4*)(gn + c) * (*(const f32x4*)(sc + c) + 1.0f); }
        bf16_t* xs = XS + (size_t)u.pm * BM * DM; float* ssp = SS + (size_t)(u.pn * 4 + wc) * NROW + u.pm * BM;
#pragma unroll
        for (int ai = 0; ai < 2; ++ai)
#pragma unroll
            for (int mh = 0; mh < 2; ++mh) {
                f32x4 xv[2][2][2];
#pragma unroll
                for (int m2 = 0; m2 < 2; ++m2) { const int rt_ = row0 + ai * HALF + (mh * 2 + m2) * 16;
#pragma unroll
                    for (int bj = 0; bj < 2; ++bj) {
                        if constexpr (INF32) { xv[m2][bj][0] = *(const f32x4*)(xif + (size_t)rt_ * DM + col0 + bj * HALF); xv[m2][bj][1] = *(const f32x4*)(xif + (size_t)rt_ * DM + col0 + bj * HALF + 4); }
                        else { const u32x4 q = *(const u32x4*)(xib + (size_t)rt_ * XST + col0 + bj * HALF);
                            xv[m2][bj][0] = (f32x4){__uint_as_float(q.x << 16), __uint_as_float(q.x & 0xffff0000u), __uint_as_float(q.y << 16), __uint_as_float(q.y & 0xffff0000u)};
                            xv[m2][bj][1] = (f32x4){__uint_as_float(q.z << 16), __uint_as_float(q.z & 0xffff0000u), __uint_as_float(q.w << 16), __uint_as_float(q.w & 0xffff0000u)}; } } }
#pragma unroll
                for (int m2 = 0; m2 < 2; ++m2) { const int rt_ = row0 + ai * HALF + (mh * 2 + m2) * 16; float ss = 0.f;
#pragma unroll
                    for (int bj = 0; bj < 2; ++bj) { f32x4 y[2];
#pragma unroll
                        for (int n = 0; n < 2; ++n) { y[n] = xv[m2][bj][n] + gv[bj][n] * acc[ai][bj][mh * 2 + m2][n];
                            ss += (y[n][0] * y[n][0] + y[n][1] * y[n][1]) + (y[n][2] * y[n][2] + y[n][3] * y[n][3]); }
                        u32x4 w; w.x = cvt_pk_bf16(y[0][0], y[0][1]); w.y = cvt_pk_bf16(y[0][2], y[0][3]); w.z = cvt_pk_bf16(y[1][0], y[1][1]); w.w = cvt_pk_bf16(y[1][2], y[1][3]);
                        *(u32x4*)(xo + (size_t)rt_ * XST + col0 + bj * HALF) = w;
                        if constexpr (NORM) { y[0] = y[0] * gs[bj][0]; y[1] = y[1] * gs[bj][1];
                            u32x4 w2; w2.x = cvt_pk_bf16(y[0][0], y[0][1]); w2.y = cvt_pk_bf16(y[0][2], y[0][3]); w2.z = cvt_pk_bf16(y[1][0], y[1][1]); w2.w = cvt_pk_bf16(y[1][2], y[1][3]);
                            *(u32x4*)(xs + (size_t)rt_ * DM + col0 + bj * HALF) = w2; } }
                    if constexpr (NORM) { ss += __shfl_xor(ss, 16); ss += __shfl_xor(ss, 32); if (fq == 0) ssp[rt_] = ss; } }
                asm volatile("" ::: "memory"); }
    }
};
template <bool NORM>
struct EpiProj {
    static constexpr bool PERM = true;
    bf16_t* O; int ldc; const PG8_LAS float* tb; const float* rope;
    __device__ __forceinline__ void operator()(const f32x4 (&acc)[2][2][4][2], const Unit& u, int wr, int wc, int fr, int fq) const {
        const int b = u.pm / 17, jt = u.pm - 17 * b; const bool rot = jt != 0 && u.pn >= ZDQ / 256 && u.pn < ZDV / 256; const int axis = wc & 1;
        const int row0 = u.pm * BM + wr * 64 + fr, col0 = u.pn * BM + wc * 32 + 8 * fq; const PG8_LAS float* rp = tb + u.sl * 512 + wr * 64 + fr; const PG8_LAS float* sp = tb + u.sl * 512 + 256 + wc * 32 + 8 * fq;
        f32x4 s[2][2];
        if constexpr (NORM) {
#pragma unroll
            for (int bj = 0; bj < 2; ++bj)
#pragma unroll
                for (int n = 0; n < 2; ++n) s[bj][n] = *(const PG8_LAS f32x4*)(sp + bj * HALF + n * 4); }
#pragma unroll
        for (int ai = 0; ai < 2; ++ai)
#pragma unroll
            for (int m = 0; m < 4; ++m) { bf16_t* rowp = O + (size_t)(row0 + ai * HALF + m * 16) * ldc + col0; float r = 1.0f; if constexpr (NORM) r = rp[ai * HALF + m * 16];
                f32x4 c01 = {1.f, 0.f, 1.f, 0.f}, c23 = {1.f, 0.f, 1.f, 0.f};
                if (rot) { const int pos = axis ? 16 * m + fr : (jt - 1) * 4 + 2 * ai + wr; const float* cp = rope + (pos * 16 + 4 * fq) * 2; c01 = *(const f32x4*)cp; c23 = *(const f32x4*)(cp + 4); }
#pragma unroll
                for (int bj = 0; bj < 2; ++bj) { f32x4 v0 = acc[ai][bj][m][0], v1 = acc[ai][bj][m][1];
                    if constexpr (NORM) { v0 = v0 * r + s[bj][0]; v1 = v1 * r + s[bj][1]; }
                    if (rot) { f32x4 o0, o1;
                        o0[0] = v0[0] * c01[0] - v1[0] * c01[1]; o1[0] = v0[0] * c01[1] + v1[0] * c01[0]; o0[1] = v0[1] * c01[2] - v1[1] * c01[3]; o1[1] = v0[1] * c01[3] + v1[1] * c01[2];
                        o0[2] = v0[2] * c23[0] - v1[2] * c23[1]; o1[2] = v0[2] * c23[1] + v1[2] * c23[0]; o0[3] = v0[3] * c23[2] - v1[3] * c23[3]; o1[3] = v0[3] * c23[3] + v1[3] * c23[2];
                        v0 = o0; v1 = o1; }
                    u32x4 w; w.x = cvt_pk_bf16(v0[0], v0[1]); w.y = cvt_pk_bf16(v0[2], v0[3]); w.z = cvt_pk_bf16(v1[0], v1[1]); w.w = cvt_pk_bf16(v1[2], v1[3]);
                    *(u32x4*)(rowp + bj * HALF) = w; } }
    }
};
struct EpiSwigluN {
    static constexpr bool PERM = true;
    bf16_t* O; int ldc; const PG8_LAS float* tb;
    __device__ __forceinline__ void operator()(const f32x4 (&acc)[2][2][4][2], const Unit& u, int wr, int wc, int fr, int fq) const {
        const int row0 = u.pm * BM + wr * 64 + fr, col0 = u.pn * HALF + wc * 32 + 8 * fq; const PG8_LAS float* rp = tb + u.sl * 512 + wr * 64 + fr; const PG8_LAS float* sp = tb + u.sl * 512 + 256 + wc * 32 + 8 * fq;
        f32x4 s[2][2];
#pragma unroll
        for (int bj = 0; bj < 2; ++bj)
#pragma unroll
            for (int n = 0; n < 2; ++n) s[bj][n] = *(const PG8_LAS f32x4*)(sp + bj * HALF + n * 4);
#pragma unroll
        for (int ai = 0; ai < 2; ++ai)
#pragma unroll
            for (int m = 0; m < 4; ++m) { bf16_t* rowp = O + (size_t)(row0 + ai * HALF + m * 16) * ldc + col0; const float r = rp[ai * HALF + m * 16];
                f32x4 v[2];
#pragma unroll
                for (int n = 0; n < 2; ++n) { const f32x4 g = acc[ai][0][m][n] * r + s[0][n], up = acc[ai][1][m][n] * r + s[1][n]; f32x4 t, q;
#pragma unroll
                    for (int j = 0; j < 4; ++j) t[j] = __builtin_amdgcn_exp2f(-g[j]);
                    t = t + 1.0f;
#pragma unroll
                    for (int j = 0; j < 4; ++j) q[j] = __builtin_amdgcn_rcpf(t[j]);
                    v[n] = (g * up) * q; }
                u32x4 w; w.x = cvt_pk_bf16(v[0][0], v[0][1]); w.y = cvt_pk_bf16(v[0][2], v[0][3]); w.z = cvt_pk_bf16(v[1][0], v[1][1]); w.w = cvt_pk_bf16(v[1][2], v[1][3]);
                *(u32x4*)rowp = w; }
    }
};
template <class Sched>
__device__ __forceinline__ void stage_norm_tables(PG8_LAS unsigned char* lds, const float* SS, const float* sw, int swld, const Sched& S) {
    PG8_LAS float* tb = (PG8_LAS float*)(lds + GROWS_OFF); const int row = threadIdx.x & 255, half = threadIdx.x >> 8;
    Unit u0; if (!S.next(0, u0)) return;
    float part[GROWS_MAX], sv[GROWS_MAX];
#pragma unroll
    for (int i = 0; i < GROWS_MAX; ++i) { Unit u; if (!S.next(i, u)) u = u0;
        const float* sp = SS + (size_t)(half * 8) * NROW + u.pm * BM + row; float s = 0.f;
#pragma unroll
        for (int k = 0; k < 8; ++k) s += sp[(size_t)k * NROW];
        part[i] = s; const int b = u.pm / 17, mrow = (u.pm - 17 * b) == 0 ? 8 : b; sv[i] = sw[(size_t)mrow * swld + u.pn * BM + row]; }
    if (half) {
#pragma unroll
        for (int i = 0; i < GROWS_MAX; ++i) { tb[i * 512 + row] = part[i]; tb[i * 512 + 256 + row] = sv[i]; } }
    __syncthreads();
    if (!half) {
#pragma unroll
        for (int i = 0; i < GROWS_MAX; ++i) tb[i * 512 + row] = rsqrtf((tb[i * 512 + row] + part[i]) * (1.0f / DM) + RMS_EPS); }
    __syncthreads();
}

template <class Sched>
__device__ __forceinline__ void stage_gather_rows(PG8_LAS unsigned char* lds, const int* rows, const Sched& S) {
    PG8_LAS int* rl = (PG8_LAS int*)(lds + GROWS_OFF); Unit u;
    for (int i = 0; i < GROWS_MAX && S.next(i, u); ++i) if (threadIdx.x < 256) rl[i * 256 + threadIdx.x] = rows[u.ga * 256 + threadIdx.x];
    __syncthreads();
}
template <class Epi, class Sched, bool ALIGN_EPI, bool GATHER>
__device__ __forceinline__ void gemm_phase(PG8_LAS unsigned char* lds, const Gemm g, const Sched& S, const Epi& E) {
    const int tid = threadIdx.x, wid = __builtin_amdgcn_readfirstlane(tid >> 6), lane = tid & 63, wr = wid >> 2, wc = wid & 3, fr = lane & 15, fq = lane >> 4;
    const int K = g.K, nt = (g.Kloop ? g.Kloop : K) / BK;
    unsigned voffA[2], voffB[2];
#pragma unroll
    for (int i = 0; i < 2; ++i) { int R, C; stage_rc(tid * 16 + i * 8192, R, C); const int Rb = Epi::PERM ? ((R & ~31) + perm32(R & 31)) : R;
        voffA[i] = (unsigned)(R * K + C) * 2u; voffB[i] = (unsigned)(Rb * K + C) * 2u; }
    const size_t kstep = (size_t)(BK * 2);
    const size_t hstep = (size_t)HALF * K * 2;
    const size_t tstep = 2 * hstep;
    const unsigned ldsw = (unsigned)wid * 1024u;
    const int aoff = lds_byte(wr * 64 + fr, fq * 8), boff = lds_byte(wc * 32 + fr, fq * 8);
#define PG8_SA(b, h) (((b) * 2 + (h)) * HTB)
#define PG8_SB(b, h) ((4 + (b) * 2 + (h)) * HTB)
#define PG8_STAGE(bufoff, gbase, voff) do { _Pragma("unroll") for (int _i = 0; _i < 2; ++_i) \
        __builtin_amdgcn_global_load_lds((const unsigned*)((const char*)(gbase) + (voff)[_i]), (PG8_LAS unsigned*)(lds + (bufoff) + ldsw + _i * 8192), 16, 0, 0); } while (0)
#define PG8_STAGE_A(bufoff, kp, h, nx) do { if constexpr (GATHER) { unsigned _g[2] = { (nx) ? gN[h][0] : gA[h][0], (nx) ? gN[h][1] : gA[h][1] }; PG8_STAGE(bufoff, kp, _g); } \
        else { PG8_STAGE(bufoff, (kp) + (h) * hstep, voffA); } } while (0)
#define PG8_LDA(dst, b, h) do { _Pragma("unroll") for (int m = 0; m < 4; ++m) _Pragma("unroll") for (int k = 0; k < 2; ++k) dst[m][k] = *(const PG8_LAS bf16x8*)(lds + PG8_SA(b, h) + aoff + m * 2048 + k * 1024); } while (0)
#define PG8_LDB(dst, b, h) do { _Pragma("unroll") for (int n = 0; n < 2; ++n) _Pragma("unroll") for (int k = 0; k < 2; ++k) dst[n][k] = *(const PG8_LAS bf16x8*)(lds + PG8_SB(b, h) + boff + n * 2048 + k * 1024); } while (0)
#define PG8_MMA(ai, bj, At, Bt) do { __builtin_amdgcn_s_setprio(1); _Pragma("unroll") for (int m = 0; m < 4; ++m) _Pragma("unroll") for (int n = 0; n < 2; ++n) _Pragma("unroll") for (int k = 0; k < 2; ++k) \
        acc[ai][bj][m][n] = __builtin_amdgcn_mfma_f32_16x16x32_bf16(Bt[n][k], At[m][k], acc[ai][bj][m][n], 0, 0, 0); __builtin_amdgcn_s_setprio(0); } while (0)
#define PG8_WAIT_V(n) asm volatile("s_waitcnt vmcnt(" #n ")" ::: "memory")
#define PG8_WAIT_L(n) asm volatile("s_waitcnt lgkmcnt(" #n ")" ::: "memory")
#define PG8_BAR __builtin_amdgcn_s_barrier()
#define PG8_SCHED __builtin_amdgcn_sched_barrier(0)
#define PG8_GLOAD(dst, slot) do { const PG8_LAS int* rl_ = (const PG8_LAS int*)(lds + GROWS_OFF) + (slot) * 256; _Pragma("unroll") for (int _h = 0; _h < 2; ++_h) _Pragma("unroll") for (int _i = 0; _i < 2; ++_i) { int R_, C_; stage_rc(tid * 16 + _i * 8192, R_, C_); \
        dst[_h][_i] = ((unsigned)rl_[_h * 128 + R_] * (unsigned)K + (unsigned)C_) * 2u; } } while (0)
    Unit cur, nxt; int ui = 0;
    if (!S.next(0, cur)) return;
    f32x4 acc[2][2][4][2];
#pragma unroll
    for (int a = 0; a < 2; ++a)
#pragma unroll
        for (int b = 0; b < 2; ++b)
#pragma unroll
            for (int m = 0; m < 4; ++m)
#pragma unroll
                for (int n = 0; n < 2; ++n) acc[a][b][m][n] = (f32x4){0.f, 0.f, 0.f, 0.f};
    bf16x8 At[4][2], B0[2][2], B1[2][2];
    unsigned gA[2][2], gN[2][2];
    if constexpr (GATHER) { PG8_GLOAD(gA, 0); } else { gA[0][0] = gA[0][1] = gA[1][0] = gA[1][1] = 0u; }
#pragma unroll
    for (int h = 0; h < 2; ++h)
#pragma unroll
        for (int i = 0; i < 2; ++i) gN[h][i] = gA[h][i];
    const char* cA = GATHER ? (const char*)g.A : (const char*)g.A + (size_t)cur.pm * tstep + cur.ko; const char* cB = (const char*)g.Bt + cur.bo + cur.ko;
    PG8_STAGE(PG8_SB(0, 0), cB, voffB); PG8_STAGE(PG8_SB(0, 1), cB + hstep, voffB); PG8_STAGE_A(PG8_SA(0, 0), cA, 0, false); PG8_STAGE_A(PG8_SA(0, 1), cA, 1, false);
    if (wr == 1) PG8_BAR;
    PG8_WAIT_V(2); PG8_BAR;
    PG8_STAGE(PG8_SB(1, 0), cB + kstep, voffB); PG8_STAGE_A(PG8_SA(1, 0), cA + kstep, 0, false); PG8_STAGE(PG8_SB(1, 1), cB + hstep + kstep, voffB);
    PG8_WAIT_V(6); PG8_BAR;
    for (;;) {
        const bool has_next = S.next(ui + 1, nxt);
        if constexpr (GATHER) { if (has_next) { PG8_GLOAD(gN, ui + 1); } }
        const char* nA = GATHER ? cA : (has_next ? (const char*)g.A + (size_t)nxt.pm * tstep + nxt.ko : cA); const char* nB = has_next ? (const char*)g.Bt + nxt.bo + nxt.ko : cB;
        for (int t = 0; t < nt; t += 2) {
            const bool last = (t == nt - 2);
            const char* a1 = cA + (size_t)(t + 1) * kstep;
            const char* a2 = last ? nA : cA + (size_t)(t + 2) * kstep; const char* b2 = last ? nB : cB + (size_t)(t + 2) * kstep;
            const char* a3 = a2 + kstep; const char* b3 = b2 + kstep;
            PG8_LDB(B0, 0, 0); PG8_LDB(B1, 0, 1); PG8_SCHED; PG8_LDA(At, 0, 0); PG8_STAGE_A(PG8_SA(1, 1), a1, 1, false);
            PG8_WAIT_V(8); PG8_WAIT_L(0); PG8_BAR; PG8_MMA(0, 0, At, B0); PG8_MMA(0, 1, At, B1); PG8_BAR; PG8_SCHED;
            PG8_LDA(At, 0, 1); PG8_STAGE(PG8_SB(0, 0), b2, voffB); PG8_STAGE(PG8_SB(0, 1), b2 + hstep, voffB); PG8_STAGE_A(PG8_SA(0, 0), a2, 0, last);
            PG8_WAIT_V(8); PG8_WAIT_L(0); PG8_BAR; PG8_MMA(1, 0, At, B0); PG8_MMA(1, 1, At, B1); PG8_BAR; PG8_SCHED;
            PG8_LDB(B0, 1, 0); PG8_LDB(B1, 1, 1); PG8_SCHED; PG8_LDA(At, 1, 0); PG8_STAGE_A(PG8_SA(0, 1), a2, 1, last);
            PG8_WAIT_V(8); PG8_WAIT_L(0); PG8_BAR; PG8_MMA(0, 0, At, B0); PG8_MMA(0, 1, At, B1); PG8_BAR; PG8_SCHED;
            PG8_LDA(At, 1, 1); PG8_STAGE(PG8_SB(1, 0), b3, voffB); PG8_STAGE(PG8_SB(1, 1), b3 + hstep, voffB); PG8_STAGE_A(PG8_SA(1, 0), a3, 0, last);
            PG8_WAIT_V(8); PG8_WAIT_L(0); PG8_BAR; PG8_MMA(1, 0, At, B0); PG8_MMA(1, 1, At, B1); PG8_BAR; PG8_SCHED;
        }
        if constexpr (ALIGN_EPI) { if (wr == 0) PG8_BAR; }
        E(acc, cur, wr, wc, fr, fq);
        if (!has_next) break;
#pragma unroll
        for (int a = 0; a < 2; ++a)
#pragma unroll
            for (int b = 0; b < 2; ++b)
#pragma unroll
                for (int m = 0; m < 4; ++m)
#pragma unroll
                    for (int n = 0; n < 2; ++n) acc[a][b][m][n] = (f32x4){0.f, 0.f, 0.f, 0.f};
        cur = nxt; cA = nA; cB = nB; ++ui;
#pragma unroll
        for (int h = 0; h < 2; ++h)
#pragma unroll
            for (int i = 0; i < 2; ++i) gA[h][i] = gN[h][i];
        if constexpr (ALIGN_EPI) { if (wr == 1) PG8_BAR; }
    }
    PG8_WAIT_V(0);
    if constexpr (!ALIGN_EPI) { if (wr == 0) PG8_BAR; }
    PG8_BAR;
#undef PG8_SA
#undef PG8_SB
#undef PG8_STAGE
#undef PG8_STAGE_A
#undef PG8_LDA
#undef PG8_LDB
#undef PG8_MMA
#undef PG8_WAIT_V
#undef PG8_WAIT_L
#undef PG8_BAR
#undef PG8_SCHED
#undef PG8_GLOAD
}
}

#define XB_TMO      128
#define XB_XCNT(j)  (256  + 64 * (j))
#define XB_XSUB(j)  (1280 + 64 * (j))
#define XB_XGEN(j)  (2304 + 64 * (j))
#define XB_TOP      3328
#define XB_TOPGEN   3392
#define XCD_BAR_WORDS 3456
#define XB_SPIN_CAP (1u << 18)
__device__ __forceinline__ unsigned xb_ld(unsigned* p)              { return __hip_atomic_load(p, __ATOMIC_RELAXED, __HIP_MEMORY_SCOPE_AGENT); }
__device__ __forceinline__ unsigned xb_add(unsigned* p, unsigned v) { return __hip_atomic_fetch_add(p, v, __ATOMIC_RELAXED, __HIP_MEMORY_SCOPE_AGENT); }
__device__ __forceinline__ unsigned xb_xcc_id() { return (unsigned)__builtin_amdgcn_s_getreg((3 << 11) | 20) & 0xFu; }
#define XB_SPIN(cond, bar) do { unsigned _sp = 0; while (cond) { __builtin_amdgcn_s_sleep(1); \
    if ((++_sp & 255u) == 0u) { if (xb_ld(&(bar)[XB_TMO])) break; if (_sp > XB_SPIN_CAP) { atomicAdd(&(bar)[XB_TMO], 1u); break; } } } } while (0)
struct XcdBarrier { unsigned* bar; unsigned x; volatile LAS unsigned* st; };
__device__ __forceinline__ XcdBarrier xcd_barrier_post(unsigned* bar, volatile LAS unsigned* st) {
    XcdBarrier b; b.bar = bar; b.x = xb_xcc_id(); b.st = st;
    if (threadIdx.x == 0) (void)xb_add(&bar[XB_XCNT(b.x)], 1u);
    return b;
}
__device__ __forceinline__ void xcd_barrier_complete(unsigned* bar, unsigned x, unsigned& nloc, unsigned& nx) {
    const unsigned G = gridDim.x * gridDim.y * gridDim.z;
    unsigned sum, cnt, mine, sp = 0u;
    for (;;) {
        sum = 0u; cnt = 0u; mine = 0u;
#pragma unroll
        for (unsigned j = 0; j < 16; ++j) { const unsigned c = xb_ld(&bar[XB_XCNT(j)]); sum += c; cnt += (c > 0u) ? 1u : 0u; mine = (j == x) ? c : mine; }
        if (sum == G) break;
        __builtin_amdgcn_s_sleep(1);
        if ((++sp & 255u) == 0u) { if (xb_ld(&bar[XB_TMO])) break; if (sp > XB_SPIN_CAP) { atomicAdd(&bar[XB_TMO], 1u); break; } }
    }
    nloc = mine > 0u ? mine : 1u; nx = cnt > 0u ? cnt : 1u;
}
__device__ __forceinline__ void xcd_barrier(const XcdBarrier& b) {
    asm volatile("s_waitcnt vmcnt(0)" ::: "memory");
    __syncthreads();
    if (threadIdx.x == 0) {
        unsigned* bar = b.bar;
        __builtin_amdgcn_s_waitcnt(0);
        unsigned nloc = b.st[0], nx = b.st[1];
        if (nloc == 0u) { xcd_barrier_complete(bar, b.x, nloc, nx); b.st[0] = nloc; b.st[1] = nx; }
        const unsigned old = xb_add(&bar[XB_XSUB(b.x)], 1u);
        const unsigned gen = old / nloc;
        if (old + 1u == (gen + 1u) * nloc) {
            __builtin_amdgcn_fence(__ATOMIC_RELEASE, "agent");
            asm volatile("s_waitcnt vmcnt(0)" ::: "memory");
            const unsigned og = xb_add(&bar[XB_TOP], 1u);
            const unsigned tg = og / nx;
            if (og + 1u == (tg + 1u) * nx) xb_add(&bar[XB_TOPGEN], 1u);
            else XB_SPIN(xb_ld(&bar[XB_TOPGEN]) == tg, bar);
            __builtin_amdgcn_fence(__ATOMIC_ACQUIRE, "agent");
            xb_add(&bar[XB_XGEN(b.x)], 1u);
            asm volatile("s_waitcnt vmcnt(0)" ::: "memory");
        } else {
            XB_SPIN(xb_ld(&bar[XB_XGEN(b.x)]) == gen, bar);
            __builtin_amdgcn_fence(__ATOMIC_ACQUIRE, "agent");
            asm volatile("s_waitcnt vmcnt(0)" ::: "memory");
        }
    }
    __syncthreads();
}
struct Args { const float* in[24]; float* out; unsigned char* ws; int ph_lo, ph_hi; };
typedef __attribute__((address_space(4))) const Args CArgs;
struct Frame {
    LAS unsigned char* lds;
    int tid, lane, wave, G, gw, ngw;
    CArgs* ap;
    GAS float* out; GAS unsigned char* ws;
};
#define GIN(i) ((const float*)(const GAS float*)(F.ap->in[i]))
#define IN_X 0
#define IN_C 1
#define IN_CTX 2
#define IN_CCTX 3
#define IN_WMOD 4
#define IN_BMOD 5
#define IN_GN1 6
#define IN_GN2 7
#define IN_WIN 8
#define IN_WDEC 9
#define IN_BDEC 10
#define IN_GGLA 11
#define IN_LAM 12
#define IN_GDIFF 13
#define IN_RPB 14
#define IN_WOUT 15
#define IN_WG 16
#define IN_WU 17
#define IN_WD 18
#define IN_WR 19
#define IN_MG 20
#define IN_MU 21
#define IN_MD 22
#define IN_GF 23

struct TrItem { const float* W; bf16* WT; int K, Nsrc, k0, n0, r0; float scale; int perm; };
__device__ __forceinline__ void tr_load(const TrItem& t, float (&tv)[32], int lane) {
#pragma unroll
    for (int i = 0; i < 32; ++i) tv[i] = __builtin_nontemporal_load(&t.W[(size_t)(t.k0 + 2 * i + (lane >> 5)) * t.Nsrc + t.n0 + (lane & 31)]);
}
__device__ __forceinline__ void tr_finish(const TrItem& t, const float (&tv)[32], LAS float* scr, int lane) {
#pragma unroll
    for (int i = 0; i < 32; ++i) scr[(2 * i + (lane >> 5)) * 33 + (lane & 31)] = tv[i];
    asm volatile("s_waitcnt lgkmcnt(0)" ::: "memory");
    const int c = lane & 7;
#pragma unroll
    for (int j = 0; j < 4; ++j) { const int n = (lane >> 3) + 8 * j; const LAS float* s = scr + (8 * c) * 33 + n; const float sc = t.scale;
        u32x4 o; o.x = pk2(s[0 * 33] * sc, s[1 * 33] * sc); o.y = pk2(s[2 * 33] * sc, s[3 * 33] * sc); o.z = pk2(s[4 * 33] * sc, s[5 * 33] * sc); o.w = pk2(s[6 * 33] * sc, s[7 * 33] * sc);
        const int no = t.perm ? (8 * ((n & 15) >> 2) + (n & 3) + ((n >> 4) << 2)) : n;
        *(u32x4*)(t.WT + (size_t)(t.r0 + no) * t.K + t.k0 + 8 * c) = o; }
    asm volatile("s_waitcnt lgkmcnt(0)" ::: "memory");
}
__device__ __forceinline__ void tr_item(const float* W, int K, int Nsrc, int k0, int n0, bf16* WT, int r0, float scale, LAS float* scr, int lane) {
    const TrItem t{W, WT, K, Nsrc, k0, n0, r0, scale, 0}; float tv[32]; tr_load(t, tv, lane); tr_finish(t, tv, scr, lane);
}
__device__ __forceinline__ TrItem ffn_tr_desc(const float* wg, const float* wu, const float* wd, int FF, bf16* gu_t, bf16* dn_t, int it) {
    const int nb = FF / 32, per = 16 * nb;
    if (it < 2 * per) { const bool up = it >= per; const int r = up ? it - per : it; const int kb = r / nb, n0 = (r % nb) * 32;
        return TrItem{up ? wu : wg, gu_t, DM, FF, kb * 64, n0, 256 * (n0 >> 7) + (n0 & 127) + (up ? 128 : 0), up ? 0.6931471805599453f : LOG2E, 0}; }
    const int r = it - 2 * per; const int kb = r / 32, n0 = (r % 32) * 32; return TrItem{wd, dn_t, FF, DM, kb * 64, n0, n0, 1.0f, 0};
}
__device__ __forceinline__ void ffn_tr_item(const float* wg, const float* wu, const float* wd, int FF, bf16* gu_t, bf16* dn_t, int it, LAS float* scr, int lane) {
    const TrItem t = ffn_tr_desc(wg, wu, wd, FF, gu_t, dn_t, it); float tv[32]; tr_load(t, tv, lane); tr_finish(t, tv, scr, lane);
}
__device__ __forceinline__ TrItem pro_desc(const Frame& F, int it) {
    constexpr int N_IN = 1536, N_OUT = 512;
    if (it < 2 * (N_IN + N_OUT)) {
        const int l = it / (N_IN + N_OUT), r = it % (N_IN + N_OUT);
        if (r < N_IN) { const int kb = r / 96, nbk = r % 96, r0 = nbk * 32, n0 = r0 < 768 ? r0 : r0 + 32;
            const float sc = r0 < 128 ? 0.17677669529663687f : ((r0 >= ZDQ && r0 < ZDK) || (r0 >= ZNQ && r0 < ZNK)) ? QSCALE : 1.0f;
            return TrItem{GIN(IN_WIN) + (size_t)l * 1024 * 3104, (bf16*)(F.ws + (l ? W_IN1 : W_IN0)), DM, 3104, kb * 64, n0, r0, sc, (r0 >= ZDQ && r0 < ZDV) ? 1 : 0}; }
        const int q = r - N_IN, kb = q / 32, n0 = (q % 32) * 32;
        return TrItem{GIN(IN_WOUT) + (size_t)l * 1024 * 1024, (bf16*)(F.ws + (l ? W_OUT1 : W_OUT0)), DM, DM, kb * 64, n0, n0, 1.0f, 0};
    }
    return ffn_tr_desc(GIN(IN_WG), GIN(IN_WU), GIN(IN_WD), FFD, (bf16*)(F.ws + W_GU), (bf16*)(F.ws + W_DN), it - 2 * (N_IN + N_OUT));
}
constexpr int PRO_NTR = 2 * (1536 + 512) + 3 * 16 * (FFD / 32), PRO_NMOD = 2 * 96, PRO_NLG = 256;
__device__ __forceinline__ int pro_split(const Frame& F) { if (F.G < PRO_NMOD + 16) return PRO_NTR; const int s = 3 * (F.ngw - 8 * PRO_NMOD) + 8 * PRO_NMOD; return s < PRO_NTR ? s : PRO_NTR; }
__device__ __forceinline__ void tr_range(const Frame& F, LAS float* scr, int it, int stride, int lim) {
    if (it >= lim) return;
    float ta[32], tb2[32]; TrItem da = pro_desc(F, it), db = da; tr_load(da, ta, F.lane);
    for (;;) {
        const bool nb_ = it + stride < lim; if (nb_) { db = pro_desc(F, it + stride); tr_load(db, tb2, F.lane); }
        tr_finish(da, ta, scr, F.lane); it += stride; if (!nb_) break;
        const bool na_ = it + stride < lim; if (na_) { da = pro_desc(F, it + stride); tr_load(da, ta, F.lane); }
        tr_finish(db, tb2, scr, F.lane); it += stride; if (!na_) break;
    }
}
__device__ __forceinline__ void phase_transposes_rest(const Frame& F) {
    LAS float* scr = (LAS float*)(F.lds + 40960 + F.wave * 8704); const int s = pro_split(F);
    tr_range(F, scr, s + F.gw, F.ngw, PRO_NTR);
}
__device__ __forceinline__ void phase_prologue(const Frame& F) {
    LAS float* scr = (LAS float*)(F.lds + 40960 + F.wave * 8704);
    LAS float* red = (LAS float*)(F.lds + 112640);
    float* MOD = (float*)(F.ws + WS_SM);
    if ((int)blockIdx.x < PRO_NMOD) {
        for (int item = blockIdx.x; item < PRO_NMOD; item += F.G) {
            const int l = item / 96, cg = item % 96, n = cg * 64 + F.lane, k0 = F.wave * 128;
            const float* w = GIN(IN_WMOD) + ((size_t)l * 1024 + k0) * 6144 + n;
            float sc0[9], sc1[9], acc[9];
#pragma unroll
            for (int r = 0; r < 9; ++r) { const float* cv = r < 8 ? GIN(IN_C) + r * 1024 : GIN(IN_CCTX); sc0[r] = silu_f(cv[k0 + F.lane]); sc1[r] = silu_f(cv[k0 + 64 + F.lane]); acc[r] = 0.f; }
#pragma nounroll
            for (int kb = 0; kb < 128; kb += 32) { float wv[32]; int scs[9];
#pragma unroll
                for (int k = 0; k < 32; ++k) wv[k] = __builtin_nontemporal_load(&w[(size_t)(kb + k) * 6144]);
#pragma unroll
                for (int r = 0; r < 9; ++r) scs[r] = __float_as_int((kb & 64) ? sc1[r] : sc0[r]);
                const int lb = kb & 32;
#pragma unroll
                for (int k = 0; k < 32; ++k)
#pragma unroll
                    for (int r = 0; r < 9; ++r) acc[r] += __int_as_float(__builtin_amdgcn_readlane(scs[r], lb + k)) * wv[k]; }
#pragma unroll
            for (int r = 0; r < 9; ++r) red[(F.wave * 9 + r) * 64 + F.lane] = acc[r];
            __syncthreads();
            for (int t = F.tid; t < 9 * 64; t += 512) { const int r = t >> 6, ln = t & 63; float sum = GIN(IN_BMOD)[l * 6144 + cg * 64 + ln];
#pragma unroll
                for (int wv_ = 0; wv_ < 8; ++wv_) sum += red[(wv_ * 9 + r) * 64 + ln];
                MOD[((size_t)l * 9 + r) * 6144 + cg * 64 + ln] = sum; }
            __syncthreads();
        }
    }
    { const int lgw = F.ngw - 1 - F.gw;
      for (int it = lgw; it < PRO_NLG; it += F.ngw) {
            const int l = it >> 7, kb = (it >> 3) & 15, dir = (it >> 2) & 1, jq = it & 3, k = kb * 64 + F.lane;
            const float* wi = GIN(IN_WIN) + ((size_t)l * 1024 + k) * 3104 + 768 + dir * 16;
            const f32x4 z0 = *(const f32x4*)wi, z1 = *(const f32x4*)(wi + 4), z2 = *(const f32x4*)(wi + 8), z3 = *(const f32x4*)(wi + 12);
            const float zr[16] = {z0.x, z0.y, z0.z, z0.w, z1.x, z1.y, z1.z, z1.w, z2.x, z2.y, z2.z, z2.w, z3.x, z3.y, z3.z, z3.w};
            const float* wup = GIN(IN_WDEC) + ((size_t)l * 2 + dir) * 16 * 128 + jq * 32 + (F.lane & 31);
            int wu[16];
#pragma unroll
            for (int r = 0; r < 16; ++r) wu[r] = __float_as_int(wup[r * 128]);
            bf16* dst = (bf16*)(F.ws + (l ? W_IN1 : W_IN0)) + (size_t)(ZLG + dir * 128 + jq * 32) * DM + k;
#pragma unroll
            for (int j = 0; j < 32; ++j) { float s = 0.f;
#pragma unroll
                for (int r = 0; r < 16; ++r) s += zr[r] * __int_as_float(__builtin_amdgcn_readlane(wu[r], j));
                dst[(size_t)j * DM] = (bf16)f2bf(s); }
      } }
    { int it, stride, lim;
      if (F.G < PRO_NMOD + 16) { it = F.gw; stride = F.ngw; lim = PRO_NTR; }
      else if ((int)blockIdx.x >= PRO_NMOD) { it = F.gw - 8 * PRO_NMOD; stride = F.ngw - 8 * PRO_NMOD; lim = 3 * stride; }
      else { it = 3 * (F.ngw - 8 * PRO_NMOD) + F.gw; stride = PRO_NTR; lim = PRO_NTR; }
      tr_range(F, scr, it, stride, lim); }
    if (blockIdx.x == 0) {
        float* ROPE = (float*)(F.ws + WS_SM + SM_ROPE); float* LAM = (float*)(F.ws + WS_SM + SM_LAM);
        for (int i = F.tid; i < 1024; i += 512) { const int pos = i >> 4, fi = i & 15; const float inv = __builtin_amdgcn_exp2f(-(float)fi * (13.287712379549449f / 16.0f)); const float ang = (float)pos * inv;
            ROPE[2 * i] = __cosf(ang); ROPE[2 * i + 1] = __sinf(ang); }
        if (F.tid < 2) { const int l = F.tid; const float* lm = GIN(IN_LAM) + l * 256; float s1 = 0.f, s2 = 0.f;
            for (int i = 0; i < 64; ++i) { s1 += lm[i] * lm[64 + i]; s2 += lm[128 + i] * lm[192 + i]; }
            const float li = 0.8f - 0.6f * __expf(-0.3f * (float)l);
            LAM[2 * l] = __expf(s1) - __expf(s2) + li; LAM[2 * l + 1] = li; }
    }
}

__device__ __forceinline__ void norm_row(const Frame& F, const float* xr, const float* g, const float* mod, bf16* hrow, f32x4 (&h)[4]) {
    float ss = 0.f;
#pragma unroll
    for (int j = 0; j < 4; ++j) { h[j] = *(const f32x4*)(xr + 256 * j + 4 * F.lane); ss += (h[j].x * h[j].x + h[j].y * h[j].y) + (h[j].z * h[j].z + h[j].w * h[j].w); }
    const float rs = rsqrtf(wave_sum(ss) * (1.0f / DM) + RMS_EPS);
#pragma unroll
    for (int j = 0; j < 4; ++j) { const int c = 256 * j + 4 * F.lane; const f32x4 gg = *(const f32x4*)(g + c), sh = *(const f32x4*)(mod + c), sc = *(const f32x4*)(mod + 1024 + c);
        h[j] = (h[j] * rs) * gg * (sc + 1.0f) + sh;
        u32x2 o; o.x = pk2(h[j].x, h[j].y); o.y = pk2(h[j].z, h[j].w); *(u32x2*)(hrow + c) = o; }
}
__device__ __forceinline__ void phase_norm(const Frame& F, int l, int which, const float* xl, const float* xc) {
    const float* MOD = (const float*)(F.ws + WS_SM); bf16* HB = (bf16*)(F.ws + WS_HB);
    const float* g = F.ap->in[which ? IN_GN2 : IN_GN1] + l * DM;
    for (int row = F.gw; row < NROW; row += F.ngw) {
        const int b = row / RPB, rr = row - b * RPB; const bool isc = rr < CTX;
        const float* xr = isc ? xc + ((size_t)b * CTX + rr) * DM : xl + ((size_t)b * SEQ + rr - CTX) * DM;
        const float* mod = MOD + ((size_t)l * 9 + (isc ? 8 : b)) * 6144 + which * 3072;
        f32x4 h[4]; norm_row(F, xr, g, mod, HB + (size_t)row * DM, h);
    }
}
__device__ __forceinline__ float dot16(const u32x4 a, const u32x4 c, const f32x4 s0, const f32x4 s1, const f32x4 s2, const f32x4 s3) {
    float d = __uint_as_float(a.x << 16) * s0.x + __uint_as_float(a.x & 0xffff0000u) * s0.y + __uint_as_float(a.y << 16) * s0.z + __uint_as_float(a.y & 0xffff0000u) * s0.w;
    d += __uint_as_float(a.z << 16) * s1.x + __uint_as_float(a.z & 0xffff0000u) * s1.y + __uint_as_float(a.w << 16) * s1.z + __uint_as_float(a.w & 0xffff0000u) * s1.w;
    d += __uint_as_float(c.x << 16) * s2.x + __uint_as_float(c.x & 0xffff0000u) * s2.y + __uint_as_float(c.y << 16) * s2.z + __uint_as_float(c.y & 0xffff0000u) * s2.w;
    d += __uint_as_float(c.z << 16) * s3.x + __uint_as_float(c.z & 0xffff0000u) * s3.y + __uint_as_float(c.w << 16) * s3.z + __uint_as_float(c.w & 0xffff0000u) * s3.w;
    return d;
}
__device__ __forceinline__ void phase_shiftw(const Frame& F) {
    constexpr int NR = 2 * FFD + NZ, PER = 5;
    const float* MOD = (const float*)(F.ws + WS_SM); float* SWG = (float*)(F.ws + WS_SM + SM_SWGU); float* SWI = (float*)(F.ws + WS_SM + SM_SWIN);
    if (F.gw >= NR) return;
    u32x4 wa[PER], wc[PER];
#pragma unroll
    for (int i = 0; i < PER; ++i) { const int it_ = F.gw + i * F.ngw, it = it_ < NR ? it_ : F.gw; const bool gu = it < 2 * FFD;
        const bf16* wrow = (const bf16*)(F.ws + (gu ? W_GU : W_IN1)) + (size_t)(gu ? it : it - 2 * FFD) * DM + 16 * F.lane;
        wa[i] = *(const u32x4*)wrow; wc[i] = *(const u32x4*)(wrow + 8); }
#pragma unroll
    for (int r = 0; r < 9; ++r) { const float* sg = MOD + 3072 + (size_t)r * 6144 + 16 * F.lane; const float* si = MOD + (size_t)(9 + r) * 6144 + 16 * F.lane;
        const f32x4 g0 = *(const f32x4*)sg, g1 = *(const f32x4*)(sg + 4), g2 = *(const f32x4*)(sg + 8), g3 = *(const f32x4*)(sg + 12);
        const f32x4 i0 = *(const f32x4*)si, i1 = *(const f32x4*)(si + 4), i2 = *(const f32x4*)(si + 8), i3 = *(const f32x4*)(si + 12);
        float d[PER];
#pragma unroll
        for (int i = 0; i < PER; ++i) { const int it_ = F.gw + i * F.ngw, it = it_ < NR ? it_ : F.gw; const bool gu = it < 2 * FFD;
            d[i] = gu ? dot16(wa[i], wc[i], g0, g1, g2, g3) : dot16(wa[i], wc[i], i0, i1, i2, i3); }
#pragma unroll
        for (int o = 1; o < 64; o <<= 1)
#pragma unroll
            for (int i = 0; i < PER; ++i) d[i] += __shfl_xor(d[i], o);
        if (F.lane == 0) {
#pragma unroll
            for (int i = 0; i < PER; ++i) { const int it = F.gw + i * F.ngw; if (it < NR) { if (it < 2 * FFD) SWG[(size_t)r * (2 * FFD) + it] = d[i]; else SWI[(size_t)r * NZ + it - 2 * FFD] = d[i]; } } }
    }
}
__device__ __forceinline__ f32x4 ldx_bf(const float* xl, int tok, int c) { const u32x2 q = *(const u32x2*)((const bf16*)xl + (size_t)tok * (2 * DM) + c);
    return (f32x4){__uint_as_float(q.x << 16), __uint_as_float(q.x & 0xffff0000u), __uint_as_float(q.y << 16), __uint_as_float(q.y & 0xffff0000u)}; }
__device__ __forceinline__ void phase_norm_router(const Frame& F, const float* xl) {
    const int l = 1;
    const float* MOD = (const float*)(F.ws + WS_SM); bf16* HB = (bf16*)(F.ws + WS_HB);
    const float* g = GIN(IN_GN2) + l * DM; const float* wr = GIN(IN_WR);
    LAS int* lcnt = (LAS int*)(F.lds); LAS int* lbase = lcnt + 8; LAS int* ri = lcnt + 16;
    LAS float* rw = (LAS float*)(ri + 128 * 4);
    unsigned* gcnt = (unsigned*)(F.ws + WS_CTL) + CW_CNT;
    int* tok_of = (int*)(F.ws + WS_ML); u32x4* tokinfo = (u32x4*)(F.ws + WS_ML + ML_TOKINFO);
    f32x4 w0[4][4], w1[4][4];
#pragma unroll
    for (int j = 0; j < 4; ++j)
#pragma unroll
        for (int q = 0; q < 4; ++q) { const float* wp = wr + (size_t)(256 * j + 4 * F.lane + q) * 8; w0[j][q] = *(const f32x4*)wp; w1[j][q] = *(const f32x4*)(wp + 4); }
    f32x4 gg[4];
#pragma unroll
    for (int j = 0; j < 4; ++j) gg[j] = *(const f32x4*)(g + 256 * j + 4 * F.lane);
    for (int blk = blockIdx.x; blk < NLAT / 128; blk += F.G) {
        if (F.tid < 8) lcnt[F.tid] = 0;
        __syncthreads();
        const int tok0 = blk * 128 + F.wave * 16, b = tok0 / SEQ;
        const float* mod = MOD + ((size_t)l * 9 + b) * 6144 + 3072;
        f32x4 shv[4], scv[4];
#pragma unroll
        for (int j = 0; j < 4; ++j) { shv[j] = *(const f32x4*)(mod + 256 * j + 4 * F.lane); scv[j] = *(const f32x4*)(mod + 1024 + 256 * j + 4 * F.lane) + 1.0f; }
        f32x4 xn[4];
#pragma unroll
        for (int j = 0; j < 4; ++j) xn[j] = ldx_bf(xl, tok0, 256 * j + 4 * F.lane);
        for (int rr = 0; rr < 16; ++rr) {
            const int lrow = F.wave * 16 + rr, token = tok0 + rr, t = token - b * SEQ, row = b * RPB + CTX + t;
            f32x4 h[4];
#pragma unroll
            for (int j = 0; j < 4; ++j) h[j] = xn[j];
            if (rr + 1 < 16) {
#pragma unroll
                for (int j = 0; j < 4; ++j) xn[j] = ldx_bf(xl, token + 1, 256 * j + 4 * F.lane); }
            float ss = 0.f;
#pragma unroll
            for (int j = 0; j < 4; ++j) ss += (h[j].x * h[j].x + h[j].y * h[j].y) + (h[j].z * h[j].z + h[j].w * h[j].w);
            const float rs = rsqrtf(wave_sum(ss) * (1.0f / DM) + RMS_EPS);
            f32x4 la = {0.f, 0.f, 0.f, 0.f}, lb = {0.f, 0.f, 0.f, 0.f};
#pragma unroll
            for (int j = 0; j < 4; ++j) { h[j] = (h[j] * rs) * gg[j] * scv[j] + shv[j];
                u32x2 o; o.x = pk2(h[j].x, h[j].y); o.y = pk2(h[j].z, h[j].w); *(u32x2*)(HB + (size_t)row * DM + 256 * j + 4 * F.lane) = o;
                la += w0[j][0] * h[j].x + w0[j][1] * h[j].y + w0[j][2] * h[j].z + w0[j][3] * h[j].w;
                lb += w1[j][0] * h[j].x + w1[j][1] * h[j].y + w1[j][2] * h[j].z + w1[j][3] * h[j].w; }
            float lg[8] = {la.x, la.y, la.z, la.w, lb.x, lb.y, lb.z, lb.w};
#pragma unroll
            for (int e = 0; e < 8; ++e) lg[e] = wave_sum(lg[e]);
            int i1 = 0; float v1 = lg[0];
#pragma unroll
            for (int e = 1; e < 8; ++e) if (lg[e] > v1) { v1 = lg[e]; i1 = e; }
            int i2 = -1; float v2 = -3.0e38f;
#pragma unroll
            for (int e = 0; e < 8; ++e) if (e != i1 && lg[e] > v2) { v2 = lg[e]; i2 = e; }
            if (F.lane == 0) { const float wgt1 = 1.0f / (1.0f + __expf(v2 - v1));
                const int p1 = __hip_atomic_fetch_add(lcnt + i1, 1, __ATOMIC_RELAXED, __HIP_MEMORY_SCOPE_WORKGROUP), p2 = __hip_atomic_fetch_add(lcnt + i2, 1, __ATOMIC_RELAXED, __HIP_MEMORY_SCOPE_WORKGROUP);
                ri[lrow * 4 + 0] = i1; ri[lrow * 4 + 1] = i2; ri[lrow * 4 + 2] = p1; ri[lrow * 4 + 3] = p2; rw[lrow * 2] = wgt1; rw[lrow * 2 + 1] = 1.0f - wgt1; }
        }
        __syncthreads();
        if (F.tid < 8) lbase[F.tid] = (int)__hip_atomic_fetch_add(gcnt + 64 * F.tid, (unsigned)lcnt[F.tid], __ATOMIC_RELAXED, __HIP_MEMORY_SCOPE_AGENT);
        __syncthreads();
        if (F.tid < 128) { const int token = blk * 128 + F.tid; const int e1 = ri[F.tid * 4], e2 = ri[F.tid * 4 + 1]; const int p1 = lbase[e1] + ri[F.tid * 4 + 2], p2 = lbase[e2] + ri[F.tid * 4 + 3];
            tok_of[e1 * NLAT + p1] = token; tok_of[e2 * NLAT + p2] = token;
            u32x4 ti; ti.x = ((unsigned)e1 << 20) | (unsigned)p1; ti.y = ((unsigned)e2 << 20) | (unsigned)p2; ti.z = __float_as_uint(rw[F.tid * 2]); ti.w = __float_as_uint(rw[F.tid * 2 + 1]); tokinfo[token] = ti; }
        __syncthreads();
    }
}
__device__ __forceinline__ int moe_tiles(const Frame& F, int (&tb)[8], int (&cnt)[8]) {
    const unsigned* gcnt = (const unsigned*)(F.ws + WS_CTL) + CW_CNT; int t = 0;
#pragma unroll
    for (int e = 0; e < 8; ++e) { cnt[e] = (int)__builtin_amdgcn_readfirstlane((int)__hip_atomic_load(gcnt + 64 * e, __ATOMIC_RELAXED, __HIP_MEMORY_SCOPE_AGENT)); tb[e] = t; t += (cnt[e] + 255) >> 8; }
    return t;
}
__device__ __forceinline__ void phase_moe_prep(const Frame& F) {
    int tb[8], cnt[8]; const int T = moe_tiles(F, tb, cnt);
    const int* tok_of = (const int*)(F.ws + WS_ML); int* rowlist = (int*)(F.ws + WS_ML + ML_ROWLIST);
    for (int slot = blockIdx.x * 512 + F.tid; slot < T * 256; slot += F.G * 512) {
        const int tile = slot >> 8; int e = 0;
#pragma unroll
        for (int k = 1; k < 8; ++k) e += (tile >= tb[k]) ? 1 : 0;
        int tbe = 0, ce = 0;
#pragma unroll
        for (int k = 0; k < 8; ++k) { tbe = (k == e) ? tb[k] : tbe; ce = (k == e) ? cnt[k] : ce; }
        const int pos = slot - tbe * 256; int row = CTX;
        if (pos < ce) { const int token = tok_of[e * NLAT + pos]; const int b = token / SEQ; row = b * RPB + CTX + (token - b * SEQ); }
        rowlist[slot] = row;
    }
}
constexpr int MOE_PER_E = 3 * 16 * (FFE / 32), MOE_ITEMS = NEXP * MOE_PER_E;
__device__ __forceinline__ TrItem moe_desc(const Frame& F, int it) { const int e = it / MOE_PER_E, r = it % MOE_PER_E;
    return ffn_tr_desc(GIN(IN_MG) + (size_t)e * DM * FFE, GIN(IN_MU) + (size_t)e * DM * FFE, GIN(IN_MD) + (size_t)e * FFE * DM, FFE,
                       (bf16*)(F.ws + WS_MW + e * MW_STRIDE), (bf16*)(F.ws + WS_MW + e * MW_STRIDE + MW_DN), r); }
__device__ __forceinline__ void moe_convert_items(const Frame& F, int it_lo, int it_hi, int rank, int nrank) {
    LAS float* scr = (LAS float*)(F.lds + 40960 + F.wave * 8704);
    const int step = nrank * 8; int it = it_lo + rank * 8 + F.wave;
    if (it >= it_hi) return;
    float ta[32], tb2[32]; TrItem da = moe_desc(F, it), db = da;
    tr_load(da, ta, F.lane);
    for (;;) {
        const bool nb_ = it + step < it_hi; if (nb_) { db = moe_desc(F, it + step); tr_load(db, tb2, F.lane); }
        tr_finish(da, ta, scr, F.lane); it += step; if (!nb_) break;
        const bool na_ = it + step < it_hi; if (na_) { da = moe_desc(F, it + step); tr_load(da, ta, F.lane); }
        tr_finish(db, tb2, scr, F.lane); it += step; if (!na_) break;
    }
}
constexpr size_t YX_SLAB = (size_t)8 * 256 * DM;
constexpr int YX_KS = 7;
constexpr size_t WS_YX = WS_W;
static_assert(FFE % (YX_KS * 128) == 0 && YX_KS * YX_SLAB * 2 <= WS_ZB - WS_W, "overflow slabs");
__device__ __forceinline__ f32x4 unpk4(const u32x2 q) { return (f32x4){__uint_as_float(q.x << 16), __uint_as_float(q.x & 0xffff0000u), __uint_as_float(q.y << 16), __uint_as_float(q.y & 0xffff0000u)}; }
__device__ __forceinline__ void phase_final(const Frame& F) {
    int tb[8], cnt[8]; (void)moe_tiles(F, tb, cnt);
    const float* MOD = (const float*)(F.ws + WS_SM); const u32x4* tokinfo = (const u32x4*)(F.ws + WS_ML + ML_TOKINFO);
    const bf16* YB0 = (const bf16*)(F.ws + WS_YB0); const bf16* YB1 = (const bf16*)(F.ws + WS_HB); const float* gf = GIN(IN_GF);
    f32x4 gfv[4];
#pragma unroll
    for (int j = 0; j < 4; ++j) gfv[j] = *(const f32x4*)(gf + 256 * j + 4 * F.lane);
    for (int t0 = F.gw; t0 < NLAT; t0 += 4 * F.ngw) {
        u32x4 ti[4];
#pragma unroll
        for (int i = 0; i < 4; ++i) { const int token = t0 + i * F.ngw; ti[i] = tokinfo[token < NLAT ? token : t0]; }
        f32x4 x[4][4]; u32x2 ya[4][4], yb[4][4]; bool ov1[4], ov2[4]; const bf16* yp1[4]; const bf16* yp2[4];
#pragma unroll
        for (int i = 0; i < 4; ++i) { const int tk = t0 + i * F.ngw, token = tk < NLAT ? tk : t0;
            const int e1 = ti[i].x >> 20, e2 = ti[i].y >> 20; int t1 = 0, t2 = 0;
#pragma unroll
            for (int k = 0; k < 8; ++k) { t1 = (k == e1) ? tb[k] : t1; t2 = (k == e2) ? tb[k] : t2; }
            const int s1 = t1 * 256 + (int)(ti[i].x & 0xFFFFFu), s2 = t2 * 256 + (int)(ti[i].y & 0xFFFFFu);
            const bf16* YX = (const bf16*)(F.ws + WS_YX); const bool o1 = s1 >= 65536, o2 = s2 >= 65536;
            const bf16* y1 = o1 ? YX + (size_t)(s1 - 65536) * DM : s1 < PASS0_TILES * 256 ? YB0 + (size_t)s1 * DM : YB1 + (size_t)(s1 - PASS0_TILES * 256) * DM;
            const bf16* y2 = o2 ? YX + (size_t)(s2 - 65536) * DM : s2 < PASS0_TILES * 256 ? YB0 + (size_t)s2 * DM : YB1 + (size_t)(s2 - PASS0_TILES * 256) * DM;
            ov1[i] = o1; ov2[i] = o2; yp1[i] = y1; yp2[i] = y2;
#pragma unroll
            for (int j = 0; j < 4; ++j) { const int c = 256 * j + 4 * F.lane; x[i][j] = ldx_bf((const float*)F.out, token, c); ya[i][j] = *(const u32x2*)(y1 + c); yb[i][j] = *(const u32x2*)(y2 + c); } }
#pragma unroll
        for (int i = 0; i < 4; ++i) { const int token = t0 + i * F.ngw; if (token < NLAT) {
            const int b = token / SEQ; const float w1 = __uint_as_float(ti[i].z), w2 = __uint_as_float(ti[i].w);
            const float* ga = MOD + ((size_t)9 + b) * 6144 + 5120; float* xr = (float*)F.out + (size_t)token * DM; float ss = 0.f;
            f32x4 a1[4], a2[4];
#pragma unroll
            for (int j = 0; j < 4; ++j) { a1[j] = unpk4(ya[i][j]); a2[j] = unpk4(yb[i][j]); }
            if (ov1[i]) {
                for (int ks = 1; ks < YX_KS; ++ks) {
#pragma unroll
                    for (int j = 0; j < 4; ++j) a1[j] += unpk4(*(const u32x2*)(yp1[i] + (size_t)ks * YX_SLAB + 256 * j + 4 * F.lane)); } }
            if (ov2[i]) {
                for (int ks = 1; ks < YX_KS; ++ks) {
#pragma unroll
                    for (int j = 0; j < 4; ++j) a2[j] += unpk4(*(const u32x2*)(yp2[i] + (size_t)ks * YX_SLAB + 256 * j + 4 * F.lane)); } }
#pragma unroll
            for (int j = 0; j < 4; ++j) { const int c = 256 * j + 4 * F.lane; const f32x4 y = a1[j] * w1 + a2[j] * w2;
                x[i][j] = x[i][j] + *(const f32x4*)(ga + c) * y; ss += (x[i][j].x * x[i][j].x + x[i][j].y * x[i][j].y) + (x[i][j].z * x[i][j].z + x[i][j].w * x[i][j].w); }
            const float rs = rsqrtf(wave_sum(ss) * (1.0f / DM) + RMS_EPS);
#pragma unroll
            for (int j = 0; j < 4; ++j) { const int c = 256 * j + 4 * F.lane; *(f32x4*)(xr + c) = (x[i][j] * rs) * gfv[j]; } } }
    }
}
__device__ __forceinline__ float log_sigmoid_f(float x) { return fminf(x, 0.f) - __logf(1.0f + __expf(-fabsf(x))); }
__device__ __forceinline__ size_t gla_idx(int b, int dir, int h, int n) { return (size_t)((b * 2 + dir) * 4 + h) * NCH + n; }

template <int BST>
__device__ __forceinline__ float gla_cumsum(const bf16* Z, int base, int h, int dir, const float* bdec, LAS float* bc, int lane) {
    const int k = lane & 31, half = lane >> 5; const float bd = bdec[dir * 128 + h * 32 + k];
    const bf16* zp = Z + (size_t)(base + half * 32) * NZ + ZLG + dir * 128 + h * 32 + k;
    float lg[32];
#pragma unroll
    for (int s = 0; s < 32; ++s) lg[s] = log_sigmoid_f(bf2f(zp[(size_t)s * NZ]) + bd) * (1.0f / 16.0f);
    float tot = 0.f;
#pragma unroll
    for (int s = 0; s < 32; ++s) tot += lg[s];
    const float other = __shfl_xor(tot, 32);
    if (dir == 0) { float run = half ? other : 0.f;
#pragma unroll
        for (int s = 0; s < 32; ++s) { run += lg[s]; bc[(half * 32 + s) * BST + k] = run; } }
    else { float run = half ? 0.f : other;
#pragma unroll
        for (int s = 31; s >= 0; --s) { run += lg[s]; bc[(half * 32 + s) * BST + k] = run; } }
    return tot + other;
}

typedef float f32x16_t __attribute__((ext_vector_type(16)));
__device__ __forceinline__ void phase_gla_a(const Frame& F, int l) {
    const bf16* Z = (const bf16*)(F.ws + WS_ZB); float* U = (float*)(F.ws + WS_U); float* BE = (float*)(F.ws + WS_BE);
    const float* bdec = GIN(IN_BDEC) + l * 256;
    const int h = F.wave & 3, dir = F.wave >> 2, k = F.lane & 31, half = F.lane >> 5;
    const float bd = bdec[dir * 128 + h * 32 + k];
    for (int it = blockIdx.x; it < NB * NCH; it += F.G) {
        const int b = it / NCH, n = it - b * NCH, base = b * RPB + n * 64;
        const bf16* zp = Z + (size_t)(base + half * 32) * NZ + ZLG + dir * 128 + h * 32 + k;
        const bf16* kp = Z + (size_t)(base + half * 32) * NZ + ZGK + h * 32 + k;
        const bf16* vp = Z + (size_t)(base + half * 32) * NZ + ZGV + h * 64 + k;
        bf16 lgv[32], kv[32], va[32], vb[32];
#pragma unroll
        for (int s = 0; s < 32; ++s) { lgv[s] = zp[(size_t)s * NZ]; kv[s] = kp[(size_t)s * NZ]; va[s] = vp[(size_t)s * NZ]; vb[s] = vp[(size_t)s * NZ + 32]; }
        __builtin_amdgcn_sched_barrier(0);
        float lg[32];
#pragma unroll
        for (int s = 0; s < 32; ++s) lg[s] = log_sigmoid_f(bf2f(lgv[s]) + bd) * (1.0f / 16.0f);
        float tot = 0.f;
#pragma unroll
        for (int s = 0; s < 32; ++s) tot += lg[s];
        const float other = __shfl_xor(tot, 32); const float bend = tot + other;
        if (dir == 0) { float run = half ? other : 0.f;
#pragma unroll
            for (int s = 0; s < 32; ++s) { run += lg[s]; lg[s] = run; } }
        else { float run = half ? 0.f : other;
#pragma unroll
            for (int s = 31; s >= 0; --s) { run += lg[s]; lg[s] = run; } }
        const size_t gi = gla_idx(b, dir, h, n);
        if (F.lane < 32) BE[gi * 32 + F.lane] = bend;
#pragma unroll
        for (int s = 0; s < 32; ++s) lg[s] = bf2f(kv[s]) * __expf(bend - lg[s]);
        f32x16_t acc0, acc1;
#pragma unroll
        for (int r = 0; r < 16; ++r) { acc0[r] = 0.f; acc1[r] = 0.f; }
#pragma unroll
        for (int t = 0; t < 4; ++t) {
            u32x4 aw, b0, b1;
            aw.x = pg8::cvt_pk_bf16(lg[8 * t], lg[8 * t + 1]); aw.y = pg8::cvt_pk_bf16(lg[8 * t + 2], lg[8 * t + 3]); aw.z = pg8::cvt_pk_bf16(lg[8 * t + 4], lg[8 * t + 5]); aw.w = pg8::cvt_pk_bf16(lg[8 * t + 6], lg[8 * t + 7]);
            b0.x = (unsigned)va[8 * t] | ((unsigned)va[8 * t + 1] << 16); b0.y = (unsigned)va[8 * t + 2] | ((unsigned)va[8 * t + 3] << 16); b0.z = (unsigned)va[8 * t + 4] | ((unsigned)va[8 * t + 5] << 16); b0.w = (unsigned)va[8 * t + 6] | ((unsigned)va[8 * t + 7] << 16);
            b1.x = (unsigned)vb[8 * t] | ((unsigned)vb[8 * t + 1] << 16); b1.y = (unsigned)vb[8 * t + 2] | ((unsigned)vb[8 * t + 3] << 16); b1.z = (unsigned)vb[8 * t + 4] | ((unsigned)vb[8 * t + 5] << 16); b1.w = (unsigned)vb[8 * t + 6] | ((unsigned)vb[8 * t + 7] << 16);
            acc0 = __builtin_amdgcn_mfma_f32_32x32x16_bf16(__builtin_bit_cast(bf16x8, aw), __builtin_bit_cast(bf16x8, b0), acc0, 0, 0, 0);
            acc1 = __builtin_amdgcn_mfma_f32_32x32x16_bf16(__builtin_bit_cast(bf16x8, aw), __builtin_bit_cast(bf16x8, b1), acc1, 0, 0, 0); }
        float* up = U + gi * 2048 + k;
#pragma unroll
        for (int r = 0; r < 16; ++r) { const int kk = (r & 3) + 8 * (r >> 2) + 4 * half; up[kk * 64] = acc0[r]; up[kk * 64 + 32] = acc1[r]; }
    }
}
__device__ __forceinline__ void phase_gla_scan(const Frame& F) {
    const float* U = (const float*)(F.ws + WS_U); const float* BE = (const float*)(F.ws + WS_BE); float* SP = (float*)(F.ws + WS_SP);
    for (int it = blockIdx.x; it < 256; it += F.G) {
        const int chain = it >> 2, vs = it & 3, b = chain >> 3, dir = (chain >> 2) & 1, h = chain & 3;
        const int k = F.tid >> 4, v = vs * 16 + (F.tid & 15);
        float st = 0.f;
        for (int blk = 0; blk < 4; ++blk) {
            float uu[17], dd[17];
#pragma unroll
            for (int j = 0; j < 17; ++j) { const int i = blk * 17 + j; const int n = dir == 0 ? i : (i < 4 ? 3 - i : 71 - i); const size_t gi = gla_idx(b, dir, h, n);
                uu[j] = U[gi * 2048 + k * 64 + v]; dd[j] = BE[gi * 32 + k]; }
#pragma unroll
            for (int j = 0; j < 17; ++j) { const int i = blk * 17 + j; const int n = dir == 0 ? i : (i < 4 ? 3 - i : 71 - i); const size_t gi = gla_idx(b, dir, h, n);
                SP[gi * 2048 + k * 64 + v] = st; st = __expf(dd[j]) * st + uu[j]; }
        }
    }
}
namespace dat {
using f32x16 = __attribute__((ext_vector_type(16))) float;
using s16x4 = __attribute__((ext_vector_type(4))) short;
constexpr int SHM_V = 64 * 128 * 2, SHM_K = 64 * 128 * 2;
constexpr float THR = 11.5f;
#define KSWZ(row, colB) ((row) * 256 + ((colB) ^ (((row) & 7) << 4)))
#define SBAR() __builtin_amdgcn_sched_barrier(0)
__device__ __forceinline__ int crow(int r, int hi) { return (r & 3) + 8 * (r >> 2) + 4 * hi; }
__device__ __forceinline__ unsigned cvtpk(float lo, float hi) { unsigned r; asm volatile("v_cvt_pk_bf16_f32 %0, %1, %2" : "=v"(r) : "v"(lo), "v"(hi)); return r; }
__device__ __forceinline__ void partialSM(f32x16& p0, f32x16& p1, float& m_reg, float& mn, float& alpha) {
  float pmax = p0[0];
#pragma unroll
  for (int r = 1; r < 16; ++r) pmax = fmaxf(pmax, p0[r]);
#pragma unroll
  for (int r = 0; r < 16; ++r) pmax = fmaxf(pmax, p1[r]);
  { auto rr = __builtin_amdgcn_permlane32_swap(__float_as_uint(pmax), __float_as_uint(pmax), false, false);
    pmax = fmaxf(__uint_as_float(rr[0]), __uint_as_float(rr[1])); }
  if (__builtin_expect(__all(pmax - m_reg <= THR), 1)) { mn = m_reg; alpha = 1.f; }
  else { mn = fmaxf(m_reg, pmax); alpha = __builtin_amdgcn_exp2f(m_reg - mn); m_reg = mn; }
#pragma unroll
  for (int r = 0; r < 16; ++r) p0[r] = p0[r] - mn;
#pragma unroll
  for (int r = 0; r < 16; ++r) p1[r] = p1[r] - mn;
#pragma unroll
  for (int r = 0; r < 16; ++r) p0[r] = __builtin_amdgcn_exp2f(p0[r]);
}
__device__ __forceinline__ float psm_max(const f32x16& p0, const f32x16& p1) {
  float pmax = p0[0];
#pragma unroll
  for (int r = 1; r < 16; ++r) pmax = fmaxf(pmax, p0[r]);
#pragma unroll
  for (int r = 0; r < 16; ++r) pmax = fmaxf(pmax, p1[r]);
  auto rr = __builtin_amdgcn_permlane32_swap(__float_as_uint(pmax), __float_as_uint(pmax), false, false);
  return fmaxf(__uint_as_float(rr[0]), __uint_as_float(rr[1]));
}
__device__ __forceinline__ void psm_decide(float pmax, float& m_reg, float& mn, float& alpha) {
  if (__builtin_expect(__all(pmax - m_reg <= THR), 1)) { mn = m_reg; alpha = 1.f; }
  else { mn = fmaxf(m_reg, pmax); alpha = __builtin_amdgcn_exp2f(m_reg - mn); m_reg = mn; }
}
__device__ __forceinline__ void psm_sub(f32x16& p0, f32x16& p1, float mn) {
#pragma unroll
  for (int r = 0; r < 16; ++r) { p0[r] = p0[r] - mn; p1[r] = p1[r] - mn; }
}
__device__ __forceinline__ void psm_exp0(f32x16& p0) {
#pragma unroll
  for (int r = 0; r < 16; ++r) p0[r] = __builtin_amdgcn_exp2f(p0[r]);
}
__device__ __forceinline__ void qkt_r(f32x16& p0, f32x16& p1, const LAS char* Ks, const bf16x8* qr, const f32x16& negm, int r32, int hi, int map) {
#pragma unroll
  for (int d0 = 0; d0 < 4; ++d0) { const int cb = ((map * 4 + d0) * 16 + hi * 8) * 2;
    const bf16x8 b0 = *(const LAS bf16x8*)(Ks + KSWZ(r32, cb));
    const bf16x8 b1 = *(const LAS bf16x8*)(Ks + KSWZ(32 + r32, cb));
    if (d0 == 0) { p0 = __builtin_amdgcn_mfma_f32_32x32x16_bf16(b0, qr[0], negm, 0, 0, 0); p1 = __builtin_amdgcn_mfma_f32_32x32x16_bf16(b1, qr[0], negm, 0, 0, 0); }
    else { p0 = __builtin_amdgcn_mfma_f32_32x32x16_bf16(b0, qr[d0], p0, 0, 0, 0); p1 = __builtin_amdgcn_mfma_f32_32x32x16_bf16(b1, qr[d0], p1, 0, 0, 0); } }
}
__device__ __forceinline__ void psm_decide_r(float pmax, float& m_reg, f32x16& negm, float& dl, float& alpha, bool force) {
  if (__builtin_expect(!force && __all(pmax <= THR), 1)) { dl = 0.f; alpha = 1.f; }
  else { dl = force ? pmax : fmaxf(pmax, 0.f); alpha = __builtin_amdgcn_exp2f(-dl); m_reg += dl;
#pragma unroll
    for (int r = 0; r < 16; ++r) negm[r] = -m_reg; }
}
__device__ __forceinline__ void psm_sub_r(f32x16& p0, f32x16& p1, float dl) {
  if (dl != 0.f) {
#pragma unroll
    for (int r = 0; r < 16; ++r) { p0[r] -= dl; p1[r] -= dl; } }
}
__device__ __forceinline__ void finishSM(f32x16& p0, f32x16& p1, float alpha, float& l_reg, bf16x8& pa0, bf16x8& pa1, bf16x8& pa2, bf16x8& pa3) {
#pragma unroll
  for (int r = 0; r < 16; ++r) p1[r] = __builtin_amdgcn_exp2f(p1[r]);
  float ps = 0;
#pragma unroll
  for (int r = 0; r < 16; ++r) ps += p0[r];
#pragma unroll
  for (int r = 0; r < 16; ++r) ps += p1[r];
  { auto rr = __builtin_amdgcn_permlane32_swap(__float_as_uint(ps), __float_as_uint(ps), false, false);
    ps = __uint_as_float(rr[0]) + __uint_as_float(rr[1]); }
  l_reg = l_reg * alpha + ps;
#define PK4(P, BASE, OUT) do { unsigned a0 = cvtpk(P[BASE + 0], P[BASE + 1]), a1 = cvtpk(P[BASE + 2], P[BASE + 3]);   \
    unsigned b0 = cvtpk(P[BASE + 4], P[BASE + 5]), b1 = cvtpk(P[BASE + 6], P[BASE + 7]);                              \
    auto r0 = __builtin_amdgcn_permlane32_swap(a0, b0, false, false); auto r1 = __builtin_amdgcn_permlane32_swap(a1, b1, false, false); \
    u32x4 w = {r0[0], r1[0], r0[1], r1[1]}; OUT = __builtin_bit_cast(bf16x8, w); } while (0)
  PK4(p0, 0, pa0); PK4(p0, 8, pa1); PK4(p1, 0, pa2); PK4(p1, 8, pa3);
#undef PK4
}
__device__ __forceinline__ void qkt(f32x16& p0, f32x16& p1, const LAS char* Ks, const bf16x8* qr, int r32, int hi, int map) {
  p0 = f32x16{}; p1 = f32x16{};
#pragma unroll
  for (int d0 = 0; d0 < 4; ++d0) { const int cb = ((map * 4 + d0) * 16 + hi * 8) * 2;
    const bf16x8 b0 = *(const LAS bf16x8*)(Ks + KSWZ(r32, cb));
    const bf16x8 b1 = *(const LAS bf16x8*)(Ks + KSWZ(32 + r32, cb));
    p0 = __builtin_amdgcn_mfma_f32_32x32x16_bf16(b0, qr[d0], p0, 0, 0, 0);
    p1 = __builtin_amdgcn_mfma_f32_32x32x16_bf16(b1, qr[d0], p1, 0, 0, 0); }
}
__device__ __forceinline__ int v_st(int k, int c) { const int kk = (k & ~0xC) | ((k & 4) << 1) | ((k & 8) >> 1); return ((kk >> 3) * 4 + (c >> 5)) * 512 + ((kk & 7) * 32 + (c & 31)) * 2; }
__device__ __forceinline__ int v_rd_base(int lane) { return ((lane & 3) << 3) | (((lane >> 2) & 3) << 6) | (((lane >> 4) & 1) << 5) | (((lane >> 5) & 1) << 8); }
constexpr int v_rd_off(int d0, int ks, int half) { return d0 * 512 + ks * 4096 + half * 2048; }
template <int OFF> __device__ __forceinline__ s16x4 tr_read(int vb) {
  s16x4 r; asm volatile("ds_read_b64_tr_b16 %0, %1 offset:%2" : "=&v"(r) : "v"(vb), "i"(OFF) : "memory"); return r;
}
template <int D0> __device__ __forceinline__ void pv_one(f32x16& od, int vb, bf16x8 pa0, bf16x8 pa1, bf16x8 pa2, bf16x8 pa3) {
  const s16x4 l0 = tr_read<v_rd_off(D0, 0, 0)>(vb), h0 = tr_read<v_rd_off(D0, 0, 1)>(vb), l1 = tr_read<v_rd_off(D0, 1, 0)>(vb), h1 = tr_read<v_rd_off(D0, 1, 1)>(vb);
  const s16x4 l2 = tr_read<v_rd_off(D0, 2, 0)>(vb), h2 = tr_read<v_rd_off(D0, 2, 1)>(vb), l3 = tr_read<v_rd_off(D0, 3, 0)>(vb), h3 = tr_read<v_rd_off(D0, 3, 1)>(vb);
  asm volatile("s_waitcnt lgkmcnt(0)" ::: "memory"); SBAR();
#define PK(L, H) (bf16x8){L[0], L[1], L[2], L[3], H[0], H[1], H[2], H[3]}
  od = __builtin_amdgcn_mfma_f32_32x32x16_bf16(pa0, PK(l0, h0), od, 0, 0, 0);
  od = __builtin_amdgcn_mfma_f32_32x32x16_bf16(pa1, PK(l1, h1), od, 0, 0, 0);
  od = __builtin_amdgcn_mfma_f32_32x32x16_bf16(pa2, PK(l2, h2), od, 0, 0, 0);
  od = __builtin_amdgcn_mfma_f32_32x32x16_bf16(pa3, PK(l3, h3), od, 0, 0, 0);
#undef PK
}
__device__ __forceinline__ void pv_d0(f32x16* o, int vb, bf16x8 pa0, bf16x8 pa1, bf16x8 pa2, bf16x8 pa3) {
  pv_one<0>(o[0], vb, pa0, pa1, pa2, pa3); pv_one<1>(o[1], vb, pa0, pa1, pa2, pa3); pv_one<2>(o[2], vb, pa0, pa1, pa2, pa3); pv_one<3>(o[3], vb, pa0, pa1, pa2, pa3);
}
template <bool CTXQ> __device__ __forceinline__ void diff_unit_fast(const Frame& F, int l, int b, int h, int qb) {
  const bf16* Z = (const bf16*)(F.ws + WS_ZB); bf16* CB = (bf16*)(F.ws + WS_CB);
  const int tid = F.tid, wid = F.wave, lane = F.lane, r32 = lane & 31, hi = lane >> 5, map = wid >> 2, qs = wid & 3;
  LAS char* lds = (LAS char*)F.lds;
  LAS char* V_lds = lds; LAS char* K_lds = lds + 3 * SHM_V;
  LAS float* wsf = (LAS float*)(lds + 3 * SHM_V + 3 * SHM_K) + wid * 64; LAS float* li_l = wsf; LAS float* al_l = wsf + 32;
  const int brow0 = b * RPB, qrow0 = brow0 + (CTXQ ? 0 : CTX) + qb * 128 + qs * 32;
  float m_reg = -1e30f, l_reg = 0; f32x16 o[4] = {}; bf16x8 qr[4];
  const bf16* Qw = Z + (size_t)(qrow0 + r32) * NZ + ZDQ + h * 128 + map * 64 + hi * 8;
#pragma unroll
  for (int d0 = 0; d0 < 4; ++d0) qr[d0] = *(const bf16x8*)(Qw + d0 * 16);
  const bf16* Kh = Z + (size_t)brow0 * NZ + ZDK + h * 128; const bf16* Vh = Z + (size_t)brow0 * NZ + ZDV + h * 128;
  const int sr = tid >> 4, sc = (tid & 15) * 8, vst0 = v_st(sr, sc), vst1 = v_st(32 + sr, sc);
  const int vb0 = (int)(unsigned)(uintptr_t)V_lds + v_rd_base(lane);
  bf16x8 sv0[2], sv1[2], sk0[2], sk1[2];
#define SLOAD(i, k0) do { sv0[i] = *(const bf16x8*)&Vh[(size_t)((k0) + sr) * NZ + sc]; sv1[i] = *(const bf16x8*)&Vh[(size_t)((k0) + 32 + sr) * NZ + sc]; \
    sk0[i] = *(const bf16x8*)&Kh[(size_t)((k0) + sr) * NZ + sc]; sk1[i] = *(const bf16x8*)&Kh[(size_t)((k0) + 32 + sr) * NZ + sc]; } while (0)
#define SWRITE(bb, i) do { *(LAS bf16x8*)(V_lds + (bb) * SHM_V + vst0) = sv0[i]; *(LAS bf16x8*)(V_lds + (bb) * SHM_V + vst1) = sv1[i]; const int kc = sc * 2; \
    *(LAS bf16x8*)(K_lds + (bb) * SHM_K + KSWZ(sr, kc)) = sk0[i]; *(LAS bf16x8*)(K_lds + (bb) * SHM_K + KSWZ(32 + sr, kc)) = sk1[i]; } while (0)
#define SWAIT() asm volatile("s_waitcnt vmcnt(4)" ::: "memory")
#define SYNC() __syncthreads()
#define PSM partialSM
#define FSM finishSM
#define PVD pv_d0
#define PV_PSM(vb_, P0, P1, MN, AL) do { float pm_; pv_one<0>(o[0], vb_, pa0, pa1, pa2, pa3); pm_ = psm_max(P0, P1); \
    pv_one<1>(o[1], vb_, pa0, pa1, pa2, pa3); psm_decide(pm_, m_reg, MN, AL); \
    pv_one<2>(o[2], vb_, pa0, pa1, pa2, pa3); psm_sub(P0, P1, MN); \
    pv_one<3>(o[3], vb_, pa0, pa1, pa2, pa3); psm_exp0(P0); } while (0)
#define RESC(a) do { if (__any((a) < 1.f)) { if (hi == 0) al_l[r32] = (a); asm volatile("s_waitcnt lgkmcnt(0)" ::: "memory"); \
    _Pragma("unroll") for (int d = 0; d < 4; ++d) _Pragma("unroll") for (int r = 0; r < 16; ++r) o[d][r] *= al_l[crow(r, hi)]; } } while (0)
  f32x16 pA0, pA1, pB0, pB1; float mnA, mnB, alA, alB; bf16x8 pa0, pa1, pa2, pa3; constexpr int NT = CTXQ ? 4 : NCH;
  SYNC();
  SLOAD(0, 0); asm volatile("s_waitcnt vmcnt(0)" ::: "memory"); SWRITE(0, 0); SYNC();
  qkt(pA0, pA1, K_lds, qr, r32, hi, map); PSM(pA0, pA1, m_reg, mnA, alA);
  SLOAD(1, 64); SLOAD(0, 128);
  SWAIT(); SWRITE(1, 1); SYNC();
  int bj = 1, bn = 2, bp = 0;
#define ROT3() do { const int t_ = bp; bp = bj; bj = bn; bn = t_; } while (0)
  for (int j = 1; j + 1 < NT; j += 2) {
    SBAR(); qkt(pB0, pB1, K_lds + bj * SHM_K, qr, r32, hi, map);
    FSM(pA0, pA1, alA, l_reg, pa0, pa1, pa2, pa3); SBAR();
    SLOAD(1, (j + 2) * 64); SBAR();
    PV_PSM(vb0 + bp * SHM_V, pB0, pB1, mnB, alB);
    SWAIT(); SWRITE(bn, 0);
    RESC(alB); SYNC(); ROT3();
    SBAR(); qkt(pA0, pA1, K_lds + bj * SHM_K, qr, r32, hi, map);
    FSM(pB0, pB1, alB, l_reg, pa0, pa1, pa2, pa3); SBAR();
    if (j + 3 < NT) SLOAD(0, (j + 3) * 64); SBAR();
    PV_PSM(vb0 + bp * SHM_V, pA0, pA1, mnA, alA);
    SWAIT(); if (j + 2 < NT) SWRITE(bn, 1);
    RESC(alA); SYNC(); ROT3();
  }
  SBAR(); qkt(pB0, pB1, K_lds + bj * SHM_K, qr, r32, hi, map);
  FSM(pA0, pA1, alA, l_reg, pa0, pa1, pa2, pa3); SBAR();
  PV_PSM(vb0 + bp * SHM_V, pB0, pB1, mnB, alB);
  RESC(alB);
  FSM(pB0, pB1, alB, l_reg, pa0, pa1, pa2, pa3); SBAR();
  PVD(o, vb0 + bj * SHM_V, pa0, pa1, pa2, pa3);
#undef ROT3
  if (hi == 0) li_l[r32] = l_reg; asm volatile("s_waitcnt lgkmcnt(0)" ::: "memory");
  float rli[16];
#pragma unroll
  for (int r = 0; r < 16; ++r) rli[r] = __builtin_amdgcn_rcpf(li_l[crow(r, hi)]);
  __syncthreads();
  LAS float* X = (LAS float*)lds + qs * 4096 + lane;
  if (map == 1) {
#pragma unroll
    for (int d0 = 0; d0 < 4; ++d0)
#pragma unroll
      for (int r = 0; r < 16; ++r) X[(d0 * 16 + r) * 64] = o[d0][r] * rli[r];
  }
  __syncthreads();
  if (map == 0) {
    const float* LAM = (const float*)(F.ws + WS_SM + SM_LAM); const float lam = LAM[2 * l], li = LAM[2 * l + 1];
    const float* gd = GIN(IN_GDIFF) + l * 128;
    float g4[4];
#pragma unroll
    for (int d0 = 0; d0 < 4; ++d0) g4[d0] = gd[d0 * 32 + r32] * (1.0f - li);
#pragma unroll
    for (int r = 0; r < 16; ++r) { float ss = 0.f;
#pragma unroll
      for (int d0 = 0; d0 < 4; ++d0) { const float v = o[d0][r] * rli[r] - lam * X[(d0 * 16 + r) * 64]; o[d0][r] = v; ss += v * v; }
      ss += __shfl_xor(ss, 1); ss += __shfl_xor(ss, 2); ss += __shfl_xor(ss, 4); ss += __shfl_xor(ss, 8); ss += __shfl_xor(ss, 16);
      const float rs = rsqrtf(ss * (1.0f / 128.0f) + RMS_EPS);
      bf16* op = CB + (size_t)(qrow0 + crow(r, hi)) * DM + 256 + h * 128 + r32;
#pragma unroll
      for (int d0 = 0; d0 < 4; ++d0) op[d0 * 32] = (bf16)f2bf(o[d0][r] * rs * g4[d0]); }
  }
#undef SLOAD
#undef SWRITE
#undef SWAIT
#undef RESC
#undef SYNC
#undef PSM
#undef FSM
#undef PVD
#undef PV_PSM
}

__device__ __forceinline__ void diff_unit_dma2(const Frame& F, int l, int b, int h, int qb) {
  const bf16* Z = (const bf16*)(F.ws + WS_ZB); bf16* CB = (bf16*)(F.ws + WS_CB);
  const int wid = F.wave, lane = F.lane, r32 = lane & 31, hi = lane >> 5, map = wid >> 2, qs = wid & 3;
  LAS char* lds = (LAS char*)F.lds;
  LAS char* V_lds = lds; LAS char* K_lds = lds + 4 * SHM_V;
  LAS float* wsf = (LAS float*)(lds + 4 * SHM_V + 3 * SHM_K) + wid * 64; LAS float* li_l = wsf; LAS float* al_l = wsf + 32;
  const int brow0 = b * RPB, qrow0 = brow0 + CTX + qb * 128 + qs * 32;
  float m_reg = 0.f, l_reg = 0; f32x16 o[4] = {}; f32x16 negm = {}; bf16x8 qr[4];
  const bf16* Qw = Z + (size_t)(qrow0 + r32) * NZ + ZDQ + h * 128 + map * 64 + hi * 8;
#pragma unroll
  for (int d0 = 0; d0 < 4; ++d0) qr[d0] = *(const bf16x8*)(Qw + d0 * 16);
  const bf16* Kh = Z + (size_t)brow0 * NZ + ZDK + h * 128; const bf16* Vh = Z + (size_t)brow0 * NZ + ZDV + h * 128;
  const int vb0 = (int)(unsigned)(uintptr_t)V_lds + v_rd_base(lane);
  unsigned ksrc[2], vsrc[2];
#pragma unroll
  for (int i = 0; i < 2; ++i) { const int pc = wid * 2 + i; const int krow = pc * 4 + (lane >> 4), kch = (lane & 15) ^ (krow & 7); ksrc[i] = (unsigned)(krow * NZ + kch * 8);
    const int st = pc * 2 + (lane >> 5), slot = lane & 31, kk = (st >> 2) * 8 + (slot >> 2), kq = (kk & ~0xC) | ((kk & 4) << 1) | ((kk & 8) >> 1), cc = (st & 3) * 32 + (slot & 3) * 8;
    vsrc[i] = (unsigned)(kq * NZ + cc); }
  constexpr int NT = NCH;
#define DMA_TILE(t, kb_, vb_) do { const bf16* kt_ = Kh + (size_t)(t) * 64 * NZ; const bf16* vt_ = Vh + (size_t)(t) * 64 * NZ; const int ks_ = (kb_) * SHM_K + wid * 2048, vs_ = (vb_) * SHM_V + wid * 2048; \
    _Pragma("unroll") for (int i_ = 0; i_ < 2; ++i_) { \
      __builtin_amdgcn_global_load_lds((const GAS unsigned*)(kt_ + ksrc[i_]), (LAS unsigned*)(K_lds + ks_ + i_ * 1024), 16, 0, 0); \
      __builtin_amdgcn_global_load_lds((const GAS unsigned*)(vt_ + vsrc[i_]), (LAS unsigned*)(V_lds + vs_ + i_ * 1024), 16, 0, 0); } } while (0)
#define RBAR() do { asm volatile("s_waitcnt lgkmcnt(0)" ::: "memory"); __builtin_amdgcn_s_barrier(); asm volatile("" ::: "memory"); } while (0)
#define RESC(a) do { if (__any((a) < 1.f)) { if (hi == 0) al_l[r32] = (a); asm volatile("s_waitcnt lgkmcnt(0)" ::: "memory"); \
    _Pragma("unroll") for (int d = 0; d < 4; ++d) _Pragma("unroll") for (int r = 0; r < 16; ++r) o[d][r] *= al_l[crow(r, hi)]; } } while (0)
#define PV_PSM(vb_, P0, P1, MN, AL) do { float pm_; pv_one<0>(o[0], vb_, pa0, pa1, pa2, pa3); pm_ = psm_max(P0, P1); \
    pv_one<1>(o[1], vb_, pa0, pa1, pa2, pa3); psm_decide_r(pm_, m_reg, negm, MN, AL, false); \
    pv_one<2>(o[2], vb_, pa0, pa1, pa2, pa3); psm_sub_r(P0, P1, MN); \
    pv_one<3>(o[3], vb_, pa0, pa1, pa2, pa3); psm_exp0(P0); } while (0)
  f32x16 pA0, pA1, pB0, pB1; float mnA, mnB, alA, alB; bf16x8 pa0, pa1, pa2, pa3;
  asm volatile("s_waitcnt vmcnt(0)" ::: "memory");
  __syncthreads();
  DMA_TILE(0, 0, 0); DMA_TILE(1, 1, 1);
  asm volatile("s_waitcnt vmcnt(4)" ::: "memory"); RBAR();
  qkt_r(pA0, pA1, K_lds, qr, negm, r32, hi, map); { const float pm0 = psm_max(pA0, pA1); psm_decide_r(pm0, m_reg, negm, mnA, alA, true); psm_sub_r(pA0, pA1, mnA); psm_exp0(pA0); }
  DMA_TILE(2, 2, 2);
  asm volatile("s_waitcnt vmcnt(4)" ::: "memory"); RBAR();
  int kj = 1, vj = 1;
#define STEP(PC0, PC1, MNC, ALC, PP0, PP1, ALP, j) do { \
    SBAR(); qkt_r(PC0, PC1, K_lds + kj * SHM_K, qr, negm, r32, hi, map); \
    finishSM(PP0, PP1, ALP, l_reg, pa0, pa1, pa2, pa3); SBAR(); \
    if ((j) + 2 < NT) { const int k2_ = kj == 0 ? 2 : kj - 1, v2_ = (vj + 2) & 3; DMA_TILE((j) + 2, k2_, v2_); } SBAR(); \
    PV_PSM(vb0 + ((vj + 3) & 3) * SHM_V, PC0, PC1, MNC, ALC); \
    RESC(ALC); \
    if ((j) + 2 < NT) asm volatile("s_waitcnt vmcnt(4)" ::: "memory"); else asm volatile("s_waitcnt vmcnt(0)" ::: "memory"); \
    RBAR(); kj = kj == 2 ? 0 : kj + 1; vj = (vj + 1) & 3; } while (0)
  for (int j = 1; j + 1 < NT; j += 2) {
    STEP(pB0, pB1, mnB, alB, pA0, pA1, alA, j);
    STEP(pA0, pA1, mnA, alA, pB0, pB1, alB, j + 1);
  }
  SBAR(); qkt_r(pB0, pB1, K_lds + kj * SHM_K, qr, negm, r32, hi, map);
  finishSM(pA0, pA1, alA, l_reg, pa0, pa1, pa2, pa3); SBAR();
  PV_PSM(vb0 + ((vj + 3) & 3) * SHM_V, pB0, pB1, mnB, alB);
  RESC(alB);
  finishSM(pB0, pB1, alB, l_reg, pa0, pa1, pa2, pa3); SBAR();
  pv_d0(o, vb0 + vj * SHM_V, pa0, pa1, pa2, pa3);
  if (hi == 0) li_l[r32] = l_reg; asm volatile("s_waitcnt lgkmcnt(0)" ::: "memory");
  float rli[16];
#pragma unroll
  for (int r = 0; r < 16; ++r) rli[r] = __builtin_amdgcn_rcpf(li_l[crow(r, hi)]);
  __syncthreads();
  LAS float* X = (LAS float*)lds + qs * 4096 + lane;
  if (map == 1) {
#pragma unroll
    for (int d0 = 0; d0 < 4; ++d0)
#pragma unroll
      for (int r = 0; r < 16; ++r) X[(d0 * 16 + r) * 64] = o[d0][r] * rli[r];
  }
  __syncthreads();
  if (map == 0) {
    const float* LAM = (const float*)(F.ws + WS_SM + SM_LAM); const float lam = LAM[2 * l], li = LAM[2 * l + 1];
    const float* gd = GIN(IN_GDIFF) + l * 128;
    float g4[4];
#pragma unroll
    for (int d0 = 0; d0 < 4; ++d0) g4[d0] = gd[d0 * 32 + r32] * (1.0f - li);
#pragma unroll
    for (int r = 0; r < 16; ++r) { float ss = 0.f;
#pragma unroll
      for (int d0 = 0; d0 < 4; ++d0) { const float v = o[d0][r] * rli[r] - lam * X[(d0 * 16 + r) * 64]; o[d0][r] = v; ss += v * v; }
      ss += __shfl_xor(ss, 1); ss += __shfl_xor(ss, 2); ss += __shfl_xor(ss, 4); ss += __shfl_xor(ss, 8); ss += __shfl_xor(ss, 16);
      const float rs = rsqrtf(ss * (1.0f / 128.0f) + RMS_EPS);
      bf16* op = CB + (size_t)(qrow0 + crow(r, hi)) * DM + 256 + h * 128 + r32;
#pragma unroll
      for (int d0 = 0; d0 < 4; ++d0) op[d0 * 32] = (bf16)f2bf(o[d0][r] * rs * g4[d0]); }
  }
#undef DMA_TILE
#undef RBAR
#undef RESC
#undef PV_PSM
#undef STEP
}
template <bool CTXQ> __device__ __forceinline__ void na_unit_fast(const Frame& F, int l, int b, int hp, int rp) {
  const bf16* Z = (const bf16*)(F.ws + WS_ZB); bf16* CB = (bf16*)(F.ws + WS_CB);
  const int tid = F.tid, wid = F.wave, lane = F.lane, r32 = lane & 31, hi = lane >> 5, hh = wid >> 2, h = hp * 2 + hh;
  const int qrw = 2 * rp + ((wid >> 1) & 1), qc = 32 * (wid & 1) + r32;
  LAS char* lds = (LAS char*)F.lds;
  LAS char* V_lds = lds; LAS char* K_lds = lds + 3 * SHM_V;
  LAS float* wsf = (LAS float*)(lds + 3 * SHM_V + 3 * SHM_K) + wid * 64; LAS float* li_l = wsf; LAS float* al_l = wsf + 32;
  LAS float* rpbl = (LAS float*)(lds + 3 * SHM_V + 3 * SHM_K + 2048);
  const int brow0 = b * RPB, qrow = CTXQ ? brow0 + rp * 128 + (wid & 3) * 32 + r32 : brow0 + CTX + qrw * 64 + qc;
  const int kr0 = min(max(2 * rp - 4, 0), 56), kr1 = min(max(2 * rp - 3, 0), 56) + 7, nt = CTXQ ? 4 : 4 + (kr1 - kr0 + 1);
  const int rs_q = min(max(qrw - 4, 0), 56), cst = min(max(qc - 8, 0), 48);
  float m_reg = -1e30f, l_reg = 0; f32x16 o[2] = {}; bf16x8 qr[4];
  const bf16* Qw = Z + (size_t)qrow * NZ + ZNQ + h * 64 + hi * 8;
#pragma unroll
  for (int d0 = 0; d0 < 4; ++d0) qr[d0] = *(const bf16x8*)(Qw + d0 * 16);
  const bf16* Kh = Z + (size_t)brow0 * NZ + ZNK + hp * 128; const bf16* Vh = Z + (size_t)brow0 * NZ + ZNV + hp * 128;
  const int vb0 = (int)(unsigned)(uintptr_t)V_lds + v_rd_base(lane);
  unsigned ksrc[2], vsrc[2];
#pragma unroll
  for (int i = 0; i < 2; ++i) { const int pc = wid * 2 + i; const int krow = pc * 4 + (lane >> 4), kch = (lane & 15) ^ (krow & 7); ksrc[i] = (unsigned)(krow * NZ + kch * 8);
    const int st = pc * 2 + (lane >> 5), slot = lane & 31, kk = (st >> 2) * 8 + (slot >> 2), kq = (kk & ~0xC) | ((kk & 4) << 1) | ((kk & 8) >> 1), cc = (st & 3) * 32 + (slot & 3) * 8;
    vsrc[i] = (unsigned)(kq * NZ + cc); }
#define TROW(t) (64 * ((t) < 4 ? (t) : 4 + kr0 + (t) - 4))
#define DMA_TILE(t, rb_) do { const bf16* kt_ = Kh + (size_t)TROW(t) * NZ; const bf16* vt_ = Vh + (size_t)TROW(t) * NZ; const int ks_ = (rb_) * SHM_K + wid * 2048, vs_ = (rb_) * SHM_V + wid * 2048; \
    _Pragma("unroll") for (int i_ = 0; i_ < 2; ++i_) { \
      __builtin_amdgcn_global_load_lds((const GAS unsigned*)(kt_ + ksrc[i_]), (LAS unsigned*)(K_lds + ks_ + i_ * 1024), 16, 0, 0); \
      __builtin_amdgcn_global_load_lds((const GAS unsigned*)(vt_ + vsrc[i_]), (LAS unsigned*)(V_lds + vs_ + i_ * 1024), 16, 0, 0); } } while (0)
#define RBAR() do { asm volatile("s_waitcnt lgkmcnt(0)" ::: "memory"); __builtin_amdgcn_s_barrier(); asm volatile("" ::: "memory"); } while (0)
  __syncthreads();
  if (!CTXQ) { const float* rp_g = GIN(IN_RPB) + (size_t)(l * 4 + hp * 2) * 465; for (int i = tid; i < 930; i += 512) rpbl[i] = rp_g[i] * LOG2E; }
  asm volatile("s_waitcnt vmcnt(0)" ::: "memory");
  DMA_TILE(0, 0); if (1 < nt) DMA_TILE(1, 1);
  if (1 < nt) asm volatile("s_waitcnt vmcnt(4)" ::: "memory"); else asm volatile("s_waitcnt vmcnt(0)" ::: "memory");
  RBAR();
  f32x16 p0, p1; float mn, al; bf16x8 pa0, pa1, pa2, pa3;
#define NA_STEP(t, bb) do { \
    const int kr = kr0 + t - 4; const bool active = CTXQ || (t < 4) || (kr >= rs_q && kr <= rs_q + 7); \
    if (active) { \
      qkt(p0, p1, K_lds + bb * SHM_K, qr, r32, hi, hh); \
      if (!CTXQ && t >= 4) { const LAS float* bt = rpbl + hh * 465 + (kr - qrw + 7) * 31 + 15 - qc; \
_Pragma("unroll") \
        for (int r = 0; r < 16; ++r) { const int kc = crow(r, hi); const bool ok0 = (kc >= cst) && (kc < cst + 16), ok1 = (kc + 32 >= cst) && (kc + 32 < cst + 16); \
          p0[r] = ok0 ? p0[r] + bt[kc] : -1.0e30f; p1[r] = ok1 ? p1[r] + bt[kc + 32] : -1.0e30f; } } \
      partialSM(p0, p1, m_reg, mn, al); \
      if (__any(al < 1.f)) { if (hi == 0) al_l[r32] = al; asm volatile("s_waitcnt lgkmcnt(0)" ::: "memory"); \
_Pragma("unroll") \
        for (int d = 0; d < 2; ++d) \
_Pragma("unroll") \
          for (int r = 0; r < 16; ++r) o[d][r] *= al_l[crow(r, hi)]; } \
      finishSM(p0, p1, al, l_reg, pa0, pa1, pa2, pa3); SBAR(); \
      if (hh == 0) { pv_one<0>(o[0], vb0 + bb * SHM_V, pa0, pa1, pa2, pa3); pv_one<1>(o[1], vb0 + bb * SHM_V, pa0, pa1, pa2, pa3); } \
      else { pv_one<2>(o[0], vb0 + bb * SHM_V, pa0, pa1, pa2, pa3); pv_one<3>(o[1], vb0 + bb * SHM_V, pa0, pa1, pa2, pa3); } \
    } \
  } while (0)
  int rb = 0;
  for (int t = 0; t < nt; ++t) {
    if (t + 2 < nt) { const int r2 = rb == 0 ? 2 : rb - 1; DMA_TILE(t + 2, r2); }
    { const int bb = rb; NA_STEP(t, bb); }
    if (t + 2 < nt) asm volatile("s_waitcnt vmcnt(4)" ::: "memory"); else asm volatile("s_waitcnt vmcnt(0)" ::: "memory");
    RBAR(); rb = rb == 2 ? 0 : rb + 1;
  }
#undef NA_STEP
#undef DMA_TILE
#undef RBAR
  if (hi == 0) li_l[r32] = l_reg; asm volatile("s_waitcnt lgkmcnt(0)" ::: "memory");
  bf16* ob = CB + (size_t)(qrow - r32) * DM + 768 + h * 64 + r32;
#pragma unroll
  for (int r = 0; r < 16; ++r) { const float rl = __builtin_amdgcn_rcpf(li_l[crow(r, hi)]); bf16* op = ob + (size_t)crow(r, hi) * DM;
    op[0] = (bf16)f2bf(o[0][r] * rl); op[32] = (bf16)f2bf(o[1][r] * rl); }
#undef TROW
}

__device__ __forceinline__ int qk_off(int row, int k) { return row * 64 + ((((k >> 3) ^ (row >> 2)) & 3) << 4) + (k & 7) * 2; }
__device__ __forceinline__ void gla_c_unit_fast(const Frame& F, int l, int b, int n) {
  const bf16* Z = (const bf16*)(F.ws + WS_ZB); const float* SPg = (const float*)(F.ws + WS_SP); bf16* CB = (bf16*)(F.ws + WS_CB);
  const float* bdec = GIN(IN_BDEC) + l * 256; const float* gg = GIN(IN_GGLA) + l * 64;
  const int tid = F.tid, wid = F.wave, lane = F.lane, r32 = lane & 31, hi = lane >> 5, h = wid >> 1, x = wid & 1;
  LAS char* lds = (LAS char*)F.lds;
  LAS char* QDs = lds; LAS char* KIs = lds + 32768; LAS char* SPt = lds + 65536; LAS char* V_lds = lds + 98304;
  const int base = b * RPB + n * 64;
  const int sr = tid >> 4, sc = (tid & 15) * 8, vst0 = v_st(sr, sc), vst1 = v_st(32 + sr, sc);
  const int dir = x, k = lane & 31, half = lane >> 5;
  const bf16* Vh = Z + (size_t)base * NZ + ZGV;
  const bf16x8 va0 = *(const bf16x8*)&Vh[(size_t)sr * NZ + sc], vc0 = *(const bf16x8*)&Vh[(size_t)(32 + sr) * NZ + sc];
  const bf16x8 va1 = *(const bf16x8*)&Vh[(size_t)sr * NZ + 128 + sc], vc1 = *(const bf16x8*)&Vh[(size_t)(32 + sr) * NZ + 128 + sc];
  const bf16* zp = Z + (size_t)(base + half * 32) * NZ + ZLG + dir * 128 + h * 32 + k;
  const bf16* qp = Z + (size_t)(base + half * 32) * NZ + ZGQ + h * 32 + k; const bf16* kp = Z + (size_t)(base + half * 32) * NZ + ZGK + h * 32 + k;
  const float* sp = SPg + gla_idx(b, dir, h, n) * 2048 + lane;
  bf16 lgv[32], qv[32], kv[32]; float spv[32];
#pragma unroll
  for (int s = 0; s < 32; ++s) lgv[s] = zp[(size_t)s * NZ];
#pragma unroll
  for (int s = 0; s < 32; ++s) { qv[s] = qp[(size_t)s * NZ]; kv[s] = kp[(size_t)s * NZ]; }
#pragma unroll
  for (int s = 0; s < 32; ++s) spv[s] = sp[s * 64];
  const float bd = bdec[dir * 128 + h * 32 + k];
  SBAR();
  __syncthreads();
  *(LAS bf16x8*)(V_lds + vst0) = va0; *(LAS bf16x8*)(V_lds + vst1) = vc0; *(LAS bf16x8*)(V_lds + SHM_V + vst0) = va1; *(LAS bf16x8*)(V_lds + SHM_V + vst1) = vc1;
  {
    float bc[32];
#pragma unroll
    for (int s = 0; s < 32; ++s) bc[s] = log_sigmoid_f(bf2f(lgv[s]) + bd) * (1.0f / 16.0f);
    float tot = 0.f;
#pragma unroll
    for (int s = 0; s < 32; ++s) tot += bc[s];
    const float other = __shfl_xor(tot, 32);
    if (dir == 0) { float run = half ? other : 0.f;
#pragma unroll
      for (int s = 0; s < 32; ++s) { run += bc[s]; bc[s] = run; } }
    else { float run = half ? 0.f : other;
#pragma unroll
      for (int s = 31; s >= 0; --s) { run += bc[s]; bc[s] = run; } }
    LAS char* qd = QDs + (h * 2 + dir) * 4096; LAS char* ki = KIs + (h * 2 + dir) * 4096;
#pragma unroll
    for (int s = 0; s < 32; ++s) { const float e = __expf(bc[s]); const int off = qk_off(half * 32 + s, k);
      *(LAS bf16*)(qd + off) = (bf16)f2bf(bf2f(qv[s]) * e); *(LAS bf16*)(ki + off) = (bf16)f2bf(bf2f(kv[s]) * __builtin_amdgcn_rcpf(e)); }
    LAS char* st = SPt + (h * 2 + dir) * 4096;
#pragma unroll
    for (int c8 = 0; c8 < 4; ++c8) { u32x4 w;
      w.x = pk2(spv[c8 * 8 + 0], spv[c8 * 8 + 1]); w.y = pk2(spv[c8 * 8 + 2], spv[c8 * 8 + 3]); w.z = pk2(spv[c8 * 8 + 4], spv[c8 * 8 + 5]); w.w = pk2(spv[c8 * 8 + 6], spv[c8 * 8 + 7]);
      *(LAS u32x4*)(st + lane * 64 + (((c8 ^ (lane >> 2)) & 3) << 4)) = w; }
  }
  __syncthreads();
  {
    const int cb = x, crow_q = 32 * cb + r32; f32x16 o[2] = {};
    bf16 gt0[16], gt1[16];
#pragma unroll
    for (int r = 0; r < 16; ++r) { const bf16* gp_ = Z + (size_t)(base + 32 * cb + crow(r, hi)) * NZ + ZGG + h * 64 + r32; gt0[r] = gp_[0]; gt1[r] = gp_[32]; }
    SBAR();
    const int vb = (int)(unsigned)(uintptr_t)V_lds + (h >> 1) * SHM_V + v_rd_base(lane);
#pragma unroll
    for (int dir = 0; dir < 2; ++dir) {
      const LAS char* qd = QDs + (h * 2 + dir) * 4096; const LAS char* ki = KIs + (h * 2 + dir) * 4096; const LAS char* st = SPt + (h * 2 + dir) * 4096;
      bf16x8 qf[2]; f32x16 p0 = {}, p1 = {};
#pragma unroll
      for (int ks = 0; ks < 2; ++ks) { qf[ks] = *(const LAS bf16x8*)(qd + qk_off(crow_q, ks * 16 + hi * 8));
        const bf16x8 b0 = *(const LAS bf16x8*)(ki + qk_off(r32, ks * 16 + hi * 8)), b1 = *(const LAS bf16x8*)(ki + qk_off(32 + r32, ks * 16 + hi * 8));
        p0 = __builtin_amdgcn_mfma_f32_32x32x16_bf16(b0, qf[ks], p0, 0, 0, 0); p1 = __builtin_amdgcn_mfma_f32_32x32x16_bf16(b1, qf[ks], p1, 0, 0, 0); }
#pragma unroll
      for (int r = 0; r < 16; ++r) { const int s0 = crow(r, hi), s1 = 32 + s0;
        const bool k0 = dir == 0 ? (s0 <= crow_q) : (s0 >= crow_q), k1 = dir == 0 ? (s1 <= crow_q) : (s1 >= crow_q);
        p0[r] = k0 ? p0[r] : 0.f; p1[r] = k1 ? p1[r] : 0.f; }
      bf16x8 pa0, pa1, pa2, pa3;
#define PK4(P, BASE, OUT) do { unsigned a0 = cvtpk(P[BASE + 0], P[BASE + 1]), a1 = cvtpk(P[BASE + 2], P[BASE + 3]);   \
    unsigned b0_ = cvtpk(P[BASE + 4], P[BASE + 5]), b1_ = cvtpk(P[BASE + 6], P[BASE + 7]);                              \
    auto r0 = __builtin_amdgcn_permlane32_swap(a0, b0_, false, false); auto r1 = __builtin_amdgcn_permlane32_swap(a1, b1_, false, false); \
    u32x4 w = {r0[0], r1[0], r0[1], r1[1]}; OUT = __builtin_bit_cast(bf16x8, w); } while (0)
      PK4(p0, 0, pa0); PK4(p0, 8, pa1); PK4(p1, 0, pa2); PK4(p1, 8, pa3);
#undef PK4
      SBAR();
      if (h & 1) { pv_one<2>(o[0], vb, pa0, pa1, pa2, pa3); pv_one<3>(o[1], vb, pa0, pa1, pa2, pa3); }
      else { pv_one<0>(o[0], vb, pa0, pa1, pa2, pa3); pv_one<1>(o[1], vb, pa0, pa1, pa2, pa3); }
#pragma unroll
      for (int vbk = 0; vbk < 2; ++vbk)
#pragma unroll
        for (int ks = 0; ks < 2; ++ks) { const bf16x8 sf = *(const LAS bf16x8*)(st + qk_off(vbk * 32 + r32, ks * 16 + hi * 8));
          o[vbk] = __builtin_amdgcn_mfma_f32_32x32x16_bf16(qf[ks], sf, o[vbk], 0, 0, 0); }
    }
    const float g0 = gg[r32], g1 = gg[32 + r32];
#pragma unroll
    for (int r = 0; r < 16; ++r) { const int c = 32 * cb + crow(r, hi); float ss = o[0][r] * o[0][r] + o[1][r] * o[1][r];
      ss += __shfl_xor(ss, 1); ss += __shfl_xor(ss, 2); ss += __shfl_xor(ss, 4); ss += __shfl_xor(ss, 8); ss += __shfl_xor(ss, 16);
      const float rs = rsqrtf(ss * (1.0f / 64.0f) + RMS_EPS);
      bf16* op = CB + (size_t)(base + c) * DM + h * 64 + r32;
      op[0] = (bf16)f2bf(o[0][r] * rs * g0 * silu_f(bf2f(gt0[r]))); op[32] = (bf16)f2bf(o[1][r] * rs * g1 * silu_f(bf2f(gt1[r]))); }
  }
}
#undef KSWZ
#undef SBAR
}
__device__ __forceinline__ void phase_mixer(const Frame& F, int l) {
    const bool ctxo = (l == 0);
    { const bool xa = (F.G & 7) == 0; const int c = (int)blockIdx.x, per = F.G >> 3;
      for (int u = c, i = 0; u < NB * 4 * 32; u += F.G, ++i) { const int sq = i * per + (c >> 3); const int pr = xa ? (c & 7) + 8 * (sq >> 5) : (u >> 5), qb = xa ? (sq & 31) : (u & 31);
          dat::diff_unit_dma2(F, l, pr >> 2, pr & 3, qb); }
      for (int u = c, i = 0; u < NB * 2 * 32; u += F.G, ++i) { const int sq = i * per + (c >> 3); const int pr = xa ? (c & 7) + 8 * (sq >> 5) : (u >> 5), rp = xa ? (sq & 31) : (u & 31);
          dat::na_unit_fast<false>(F, l, pr >> 1, pr & 1, rp); } }
    const int c2 = (int)((blockIdx.x + F.G - (128 % F.G)) % F.G);
    for (int u = c2; u < NB * NCH; u += F.G) { const int n = u % NCH, b = u / NCH; if (n >= 4 || ctxo) dat::gla_c_unit_fast(F, l, b, n); }
    if (ctxo) {
        for (int u = blockIdx.x; u < NB * 4 * 2; u += F.G) { const int qb = u & 1, h = (u >> 1) & 3, b = u >> 3; dat::diff_unit_fast<true>(F, l, b, h, qb); }
        const int c3 = (int)((blockIdx.x + F.G - (64 % F.G)) % F.G);
        for (int u = c3; u < NB * 2 * 2; u += F.G) { const int qb = u & 1, hp = (u >> 1) & 1, b = u >> 2; dat::na_unit_fast<true>(F, l, b, hp, qb); }
    }
}
#ifndef MK_MULTI
#define MK_MULTI 0
#endif
constexpr int NPH = 21;
constexpr int MOE_SPLIT = MOE_ITEMS / 3, MOE_SPLIT2 = MOE_SPLIT + MOE_ITEMS / 2;
#define TAIL_CONVERT(nunits, it_lo, it_hi) do { const int nfull_ = (nunits) % F.G, c_ = (int)blockIdx.x; \
    if (nfull_ == 0) moe_convert_items(F, it_lo, it_hi, c_, F.G); else if (c_ >= nfull_) moe_convert_items(F, it_lo, it_hi, c_ - nfull_, F.G - nfull_); } while (0)
__global__ void __launch_bounds__(512, 2) fwd(Args a) {
    extern __shared__ __attribute__((aligned(16))) unsigned char lds_raw[];
    Frame F;
    F.lds = (LAS unsigned char*)lds_raw;
    F.tid = threadIdx.x; F.lane = F.tid & 63; F.wave = __builtin_amdgcn_readfirstlane(F.tid >> 6); F.G = gridDim.x;
    F.gw = blockIdx.x * 8 + F.wave; F.ngw = F.G * 8;
    F.ap = (CArgs*)__builtin_amdgcn_kernarg_segment_ptr();
    F.out = (GAS float*)a.out; F.ws = (GAS unsigned char*)a.ws;
    volatile LAS unsigned* MISC = (volatile LAS unsigned*)(F.lds + MISC_OFF);
    if (F.tid < 32) MISC[F.tid] = 0u;
    __syncthreads();
    unsigned* ctl = (unsigned*)(F.ws + WS_CTL);
    XcdBarrier bar; bar.bar = ctl + CW_BAR; bar.x = 0; bar.st = nullptr;
    if (!MK_MULTI) bar = xcd_barrier_post(ctl + CW_BAR, MISC + 8);
    const int lo = a.ph_lo, hi = a.ph_hi;
#ifndef PH_MASK
#define PH_MASK 0x1fffffu
#endif
#define IN(k) (((PH_MASK >> (k)) & 1u) && lo <= (k) && (k) < hi)
#define LAUNDER() do { CArgs* p_ = F.ap; GAS unsigned char* w_ = F.ws; GAS float* o_ = F.out; asm volatile("" : "+s"(p_), "+s"(w_), "+s"(o_)); F.ap = p_; F.ws = w_; F.out = o_; } while (0)
#define SEAM(k) do { if (!MK_MULTI && IN(k) && IN((k) + 1)) xcd_barrier(bar); else __syncthreads(); } while (0)
#define HB ((const pg8::bf16_t*)(F.ws + WS_HB))
#define XC ((float*)(F.ws + WS_XC))

    if (IN(0)) { LAUNDER(); phase_prologue(F); } SEAM(0);
    if (IN(1)) { LAUNDER(); phase_transposes_rest(F); phase_norm(F, 0, 0, GIN(IN_X), GIN(IN_CTX)); } SEAM(1);
#define LAYER_FRONT(l, pb) do { \
        if (IN(pb)) { LAUNDER(); \
            pg8::Gemm g{HB, (const pg8::bf16_t*)(F.ws + (l ? W_IN1 : W_IN0)), DM, nullptr, 0}; \
            pg8::RowOrder S{NROW / 256, NZ / 256, F.G, (int)blockIdx.x, DM, false}; \
            if (l) { pg8::stage_norm_tables(F.lds, (const float*)(F.ws + WS_SS), (const float*)(F.ws + WS_SM + SM_SWIN), NZ, S); \
                pg8::EpiProj<true> E{(pg8::bf16_t*)(F.ws + WS_ZB), NZ, (const LAS float*)(F.lds + pg8::GROWS_OFF), (const float*)(F.ws + WS_SM + SM_ROPE)}; \
                pg8::gemm_phase<pg8::EpiProj<true>, pg8::RowOrder, true, false>(F.lds, g, S, E); } \
            else { pg8::EpiProj<false> E{(pg8::bf16_t*)(F.ws + WS_ZB), NZ, (const LAS float*)(F.lds + pg8::GROWS_OFF), (const float*)(F.ws + WS_SM + SM_ROPE)}; \
                pg8::gemm_phase<pg8::EpiProj<false>, pg8::RowOrder, true, false>(F.lds, g, S, E); } \
        } SEAM(pb); \
        if (IN(pb + 1)) { LAUNDER(); phase_gla_a(F, l); if (!l) phase_shiftw(F); } SEAM(pb + 1); \
        if (IN(pb + 2)) { LAUNDER(); phase_gla_scan(F); } SEAM(pb + 2); \
        if (IN(pb + 3)) { LAUNDER(); phase_mixer(F, l); } SEAM(pb + 3); \
        if (IN(pb + 4)) { LAUNDER(); const void* xl2 = l ? (const void*)F.out : (const void*)GIN(IN_X); const void* xc2 = l ? (const void*)(F.ws + WS_XC) : (const void*)GIN(IN_CTX); \
            pg8::Gemm g{(const pg8::bf16_t*)(F.ws + WS_CB), (const pg8::bf16_t*)(F.ws + (l ? W_OUT1 : W_OUT0)), DM, nullptr, 0}; \
            pg8::RowOrder S{l ? NLAT / 256 : NROW / 256, DM / 256, F.G, (int)blockIdx.x, DM, l != 0}; \
            if (l) { pg8::EpiRes<false, false> E{xl2, xc2, (pg8::bf16_t*)F.out, (pg8::bf16_t*)(F.ws + WS_XC), (const float*)(F.ws + WS_SM) + (size_t)l * 9 * 6144 + 2048, nullptr, nullptr, nullptr, nullptr}; \
                pg8::gemm_phase<pg8::EpiRes<false, false>, pg8::RowOrder, true, false>(F.lds, g, S, E); } \
            else {     \
                pg8::EpiRes<true, true> E{xl2, xc2, (pg8::bf16_t*)F.out, (pg8::bf16_t*)(F.ws + WS_XC), (const float*)(F.ws + WS_SM) + 2048, \
                                 GIN(IN_GN2), (const float*)(F.ws + WS_SM) + 3072 + 1024, (pg8::bf16_t*)(F.ws + WS_XS), (float*)(F.ws + WS_SS)}; \
                pg8::gemm_phase<pg8::EpiRes<true, true>, pg8::RowOrder, true, false>(F.lds, g, S, E); \
                TAIL_CONVERT(NROW / 256 * (DM / 256), 0, MOE_SPLIT); } \
        } SEAM(pb + 4); } while (0)
#define MOE_PASS(p) do { \
        if (IN(16 + 2 * p)) { LAUNDER(); int tb[8], cnt[8]; const int T = moe_tiles(F, tb, cnt); \
            const int tile0 = p * PASS0_TILES, nM = p ? (T > PASS0_TILES ? T - PASS0_TILES : 0) : (T < PASS0_TILES ? T : PASS0_TILES); \
            pg8::Gemm g{HB, (const pg8::bf16_t*)(F.ws + WS_MW), DM, (const int*)(F.ws + WS_ML + ML_ROWLIST), 0}; \
            pg8::MoeOrder S; S.nM = nM; S.nN = 2 * FFE / 256; S.G = F.G; S.c = (int)blockIdx.x; S.K = DM; S.tile0 = tile0; S.estride = (long)MW_STRIDE; \
            _Pragma("unroll") for (int k = 0; k < 8; ++k) S.tb[k] = tb[k]; \
            pg8::EpiSwiglu E{(pg8::bf16_t*)(F.ws + WS_AB), FFE}; \
            pg8::stage_gather_rows(F.lds, g.rows, S); \
            pg8::gemm_phase<pg8::EpiSwiglu, pg8::MoeOrder, true, true>(F.lds, g, S, E); \
        } SEAM(16 + 2 * p); \
        if (IN(17 + 2 * p)) { LAUNDER(); int tb[8], cnt[8]; const int T = moe_tiles(F, tb, cnt); \
            const int Tn = T < 256 ? T : 256; const int tile0 = p * PASS0_TILES, nM = p ? (Tn > PASS0_TILES ? Tn - PASS0_TILES : 0) : (Tn < PASS0_TILES ? Tn : PASS0_TILES); \
            pg8::Gemm g{(const pg8::bf16_t*)(F.ws + WS_AB), (const pg8::bf16_t*)(F.ws + WS_MW + MW_DN), FFE, nullptr, 0}; \
            pg8::MoeOrder S; S.nM = nM; S.nN = DM / 256; S.G = F.G; S.c = (int)blockIdx.x; S.K = FFE; S.tile0 = tile0; S.estride = (long)MW_STRIDE; \
            _Pragma("unroll") for (int k = 0; k < 8; ++k) S.tb[k] = tb[k]; \
            pg8::EpiBf16 E{(pg8::bf16_t*)(F.ws + (p ? WS_HB : WS_YB0)), DM, 0}; \
            pg8::gemm_phase<pg8::EpiBf16, pg8::MoeOrder, true, false>(F.lds, g, S, E); \
            if (p == 1 && T > 256) {     \
                __syncthreads(); \
                pg8::Gemm g2{(const pg8::bf16_t*)(F.ws + WS_AB) + (size_t)(256 - PASS0_TILES) * 256 * FFE, (const pg8::bf16_t*)(F.ws + WS_MW + MW_DN), FFE, nullptr, FFE / YX_KS}; \
                pg8::MoeSplitOrder S2; S2.nM = T - 256; S2.nN = DM / 256; S2.KS = YX_KS; S2.G = F.G; S2.c = (int)blockIdx.x; S2.K = FFE; S2.Kloop = FFE / YX_KS; S2.tile0 = 256; S2.estride = (long)MW_STRIDE; \
                _Pragma("unroll") for (int k = 0; k < 8; ++k) S2.tb[k] = tb[k]; \
                pg8::EpiBf16 E2{(pg8::bf16_t*)(F.ws + WS_YX), DM, YX_SLAB}; \
                pg8::gemm_phase<pg8::EpiBf16, pg8::MoeSplitOrder, true, false>(F.lds, g2, S2, E2); } \
        } SEAM(17 + 2 * p); } while (0)
    LAYER_FRONT(0, 2);
    if (IN(7)) { LAUNDER();
        pg8::Gemm g{(const pg8::bf16_t*)(F.ws + WS_XS), (const pg8::bf16_t*)(F.ws + W_GU), DM, nullptr, 0};
        pg8::RowOrder S{NROW / 256, 2 * FFD / 256, F.G, (int)blockIdx.x, DM, false};
        pg8::stage_norm_tables(F.lds, (const float*)(F.ws + WS_SS), (const float*)(F.ws + WS_SM + SM_SWGU), 2 * FFD, S);
        pg8::EpiSwigluN E{(pg8::bf16_t*)(F.ws + WS_ZB), FFD, (const LAS float*)(F.lds + pg8::GROWS_OFF)};
        pg8::gemm_phase<pg8::EpiSwigluN, pg8::RowOrder, true, false>(F.lds, g, S, E);
    } SEAM(7);
    if (IN(8)) { LAUNDER();
        pg8::Gemm g{(const pg8::bf16_t*)(F.ws + WS_ZB), (const pg8::bf16_t*)(F.ws + W_DN), FFD, nullptr, 0};
        pg8::RowOrder S{NROW / 256, DM / 256, F.G, (int)blockIdx.x, FFD, false};
        pg8::EpiRes<false, true> E{(const void*)F.out, (const void*)(F.ws + WS_XC), (pg8::bf16_t*)F.out, (pg8::bf16_t*)(F.ws + WS_XC), (const float*)(F.ws + WS_SM) + 5120,
                         GIN(IN_GN1) + DM, (const float*)(F.ws + WS_SM) + (size_t)9 * 6144 + 1024, (pg8::bf16_t*)(F.ws + WS_HB), (float*)(F.ws + WS_SS)};
        pg8::gemm_phase<pg8::EpiRes<false, true>, pg8::RowOrder, true, false>(F.lds, g, S, E);
        TAIL_CONVERT(NROW / 256 * (DM / 256), MOE_SPLIT, MOE_SPLIT2);
    } SEAM(8);
    LAYER_FRONT(1, 9);
    if (IN(14)) { LAUNDER(); phase_norm_router(F, (const float*)F.out); } SEAM(14);
    if (IN(15)) { LAUNDER(); phase_moe_prep(F); moe_convert_items(F, MOE_SPLIT2, MOE_ITEMS, (int)blockIdx.x, F.G); } SEAM(15);
    MOE_PASS(0);
    MOE_PASS(1);
    if (IN(20)) { LAUNDER(); phase_final(F); }
#undef LAYER_FRONT
#undef MOE_PASS
#undef IN
#undef SEAM
#undef HB
#undef XC
}

extern "C" void kernel_launch(void* const* d_in, const int* in_sizes, int n_in, void* d_out, int out_size, void* d_ws, size_t ws_size, hipStream_t stream) {
    static int grid = 0;
    if (grid == 0) {
        if (n_in != 24 || out_size != NLAT * DM || ws_size < WS_END) { fprintf(stderr, "kernel_launch: unexpected shapes (n_in %d out %d ws %zu)\n", n_in, out_size, ws_size); grid = -1; return; }
        int dev = 0, cus = 0, per_cu = 0;
        if (hipGetDevice(&dev) != hipSuccess || hipDeviceGetAttribute(&cus, hipDeviceAttributeMultiprocessorCount, dev) != hipSuccess) { grid = -1; return; }
        if (hipFuncSetAttribute((const void*)fwd, hipFuncAttributeMaxDynamicSharedMemorySize, LDS_BYTES) != hipSuccess) { fprintf(stderr, "kernel_launch: hipFuncSetAttribute failed\n"); grid = -1; return; }
        if (hipOccupancyMaxActiveBlocksPerMultiprocessor(&per_cu, (const void*)fwd, 512, LDS_BYTES) != hipSuccess || per_cu < 1) fprintf(stderr, "kernel_launch: occupancy query says %d\n", per_cu);
        (void)hipGetLastError();
        grid = cus;
    }
    if (grid < 0) return;
    (void)hipMemsetAsync((char*)d_ws + WS_CTL, 0, CTL_ZERO_BYTES, stream);
    Args a{};
    for (int i = 0; i < 24; ++i) a.in[i] = (const float*)d_in[i];
    a.out = (float*)d_out; a.ws = (unsigned char*)d_ws;
#if MK_MULTI
    for (int p = 0; p < NPH; ++p) { a.ph_lo = p; a.ph_hi = p + 1; hipLaunchKernelGGL(fwd, dim3(grid), dim3(512), LDS_BYTES, stream, a); }
#else
    a.ph_lo = 0; a.ph_hi = NPH; hipLaunchKernelGGL(fwd, dim3(grid), dim3(512), LDS_BYTES, stream, a);
#endif
}
```
